# Optimizing an MI355X kernel written in HIP

```python
import jax, jax.numpy as jnp
from jax import lax
import numpy as np


D_MODEL = 1024
BATCH = 8
SEQ = 4096
DEPTH = 2

CTX_LEN = 256
GRID_W = 64
N_BRANCH = 4
BR_W = D_MODEL // N_BRANCH
HEAD_DIM = 64
HEADS = BR_W // HEAD_DIM
N_PARTS = 12
P_IN = N_PARTS * BR_W
CHUNK = 64
GLA_LR = 16
GLA_NORMALIZER = 16.0
RWKV_DECAY_LR = 64
RWKV_A_LR = 64
RWKV_G_LR = 160
D_FF = 2816
ROPE_BASE = 10000.0
EPS = 1e-6

kernel_name = 'hybrid_gla_retnet_rwkv7_fnet_prefix_block'


def _rmsnorm(x, g):
    xf = x.astype(jnp.float32)
    y = xf * lax.rsqrt(jnp.mean(xf * xf, axis=-1, keepdims=True) + EPS)
    return y.astype(x.dtype) * g


def _head_norm(o, g, center):
    of = o.astype(jnp.float32)
    if center:
        of = of - jnp.mean(of, axis=-1, keepdims=True)
    of = of * lax.rsqrt(jnp.mean(of * of, axis=-1, keepdims=True) + EPS)
    B, T, H, d = o.shape
    return of.reshape(B, T, H * d) * g


def _heads(x):
    B, T, _ = x.shape
    return x.reshape(B, T, HEADS, HEAD_DIM).transpose(0, 2, 1, 3)


def _unheads(x):
    return x.transpose(0, 2, 1, 3)


def _to_chunks(x):
    B, H, T, d = x.shape
    return x.reshape(B, H, T // CHUNK, CHUNK, d).transpose(2, 0, 1, 3, 4)


def _from_chunks(x):
    N, B, H, C, d = x.shape
    return x.transpose(1, 2, 0, 3, 4).reshape(B, H, N * C, d)


def _neighbours(x):
    xp = jnp.pad(x, ((0, 0), (1, 1), (0, 0)))
    return xp[:, :-2], xp[:, 2:]


def _dwconv3(x, w):
    prev, nxt = _neighbours(x)
    return prev * w[0] + x * w[1] + nxt * w[2]


def _axial_rope(T):
    rows = T // GRID_W
    row = jnp.repeat(jnp.arange(rows, dtype=jnp.float32), GRID_W)
    col = jnp.tile(jnp.arange(GRID_W, dtype=jnp.float32), rows)
    n_freq = HEAD_DIM // 4
    inv = ROPE_BASE ** (-jnp.arange(n_freq, dtype=jnp.float32) / n_freq)
    ang = jnp.concatenate([row[:, None] * inv, col[:, None] * inv], axis=-1)
    return jnp.cos(ang), jnp.sin(ang)


def _rope(x, cos, sin):
    half = x.shape[-1] // 2
    x1, x2 = x[..., :half], x[..., half:]
    return jnp.concatenate([x1 * cos - x2 * sin, x1 * sin + x2 * cos], axis=-1)


def _gla_scan(q, k, v, log_a, s0, reverse):
    if s0 is None:
        s0 = jnp.zeros(q.shape[:2] + (q.shape[-1], v.shape[-1]), jnp.float32)
    if reverse:
        q, k, v, log_a = (jnp.flip(t, axis=2) for t in (q, k, v, log_a))
    tri = jnp.tril(jnp.ones((CHUNK, CHUNK), dtype=bool))[:, :, None]

    def step(s, inp):
        qc, kc, vc, ac = inp
        b = jnp.cumsum(ac, axis=2)
        diff = b[:, :, :, None, :] - b[:, :, None, :, :]
        decay = jnp.where(tri, jnp.exp(jnp.where(tri, diff, 0.0)), 0.0)
        scores = jnp.einsum('bhid,bhjd,bhijd->bhij', qc, kc, decay)
        o = (jnp.einsum('bhij,bhje->bhie', scores, vc)
             + jnp.einsum('bhid,bhde->bhie', qc * jnp.exp(b), s))
        b_end = b[:, :, -1:, :]
        s = (jnp.swapaxes(jnp.exp(b_end), 2, 3) * s
             + jnp.einsum('bhjd,bhje->bhde', kc * jnp.exp(b_end - b), vc))
        return s, o

    s, o = lax.scan(step, s0, tuple(_to_chunks(t) for t in (q, k, v, log_a)))
    o = _from_chunks(o)
    if reverse:
        o = jnp.flip(o, axis=2)
    return o, s


def _ret_log_decay(direction):
    expo = -5.0 - jnp.arange(HEADS, dtype=jnp.float32)
    if direction == 1:
        expo = expo[::-1]
    return jnp.log1p(-jnp.exp2(expo))


def _ret_scan(q, k, v, log_g, s0, reverse):
    if s0 is None:
        s0 = jnp.zeros(q.shape[:2] + (q.shape[-1], v.shape[-1]), jnp.float32)
    if reverse:
        q, k, v = (jnp.flip(t, axis=2) for t in (q, k, v))
    pos = jnp.arange(CHUNK, dtype=jnp.float32)
    rel = pos[:, None] - pos[None, :]
    tri = rel >= 0
    dmat = jnp.where(tri, jnp.exp(jnp.where(tri, rel, 0.0) * log_g[:, None, None]), 0.0)
    q_dec = jnp.exp((pos + 1.0) * log_g[:, None])[:, :, None]
    k_dec = jnp.exp((CHUNK - 1.0 - pos) * log_g[:, None])[:, :, None]
    c_dec = jnp.exp(CHUNK * log_g)[:, None, None]

    def step(s, inp):
        qc, kc, vc = inp
        scores = jnp.einsum('bhid,bhjd->bhij', qc, kc) * dmat
        o = (jnp.einsum('bhij,bhje->bhie', scores, vc)
             + jnp.einsum('bhid,bhde->bhie', qc * q_dec, s))
        s = c_dec * s + jnp.einsum('bhjd,bhje->bhde', kc * k_dec, vc)
        return s, o

    s, o = lax.scan(step, s0, tuple(_to_chunks(t) for t in (q, k, v)))
    o = _from_chunks(o)
    if reverse:
        o = jnp.flip(o, axis=2)
    return o, s


def _rwkv_scan(r, w, k, v, a, b, s0, reverse):
    if s0 is None:
        B, T, H, d = r.shape
        s0 = jnp.zeros((B, H, d, d), jnp.float32)
    xs = tuple(jnp.moveaxis(t, 1, 0) for t in (r, w, k, v, a, b))
    if reverse:
        xs = tuple(jnp.flip(t, axis=0) for t in xs)

    def step(s, inp):
        rt, wt, kt, vt, at, bt = inp
        sa = jnp.einsum('bhvk,bhk->bhv', s, at)
        s = (s * wt[:, :, None, :] + sa[..., None] * bt[:, :, None, :]
             + vt[..., None] * kt[:, :, None, :])
        return s, jnp.einsum('bhvk,bhk->bhv', s, rt)

    s, ys = lax.scan(step, s0, xs)
    if reverse:
        ys = jnp.flip(ys, axis=0)
    return jnp.moveaxis(ys, 0, 1), s


def _bidir(scan_fn, lat_dirs, ctx_dirs):
    out_l = 0.0
    out_c = 0.0
    for dr in range(2):
        oc, sc = scan_fn(*ctx_dirs[dr], None, dr == 1)
        ol, _ = scan_fn(*lat_dirs[dr], sc, dr == 1)
        out_l = out_l + ol
        out_c = out_c + oc
    return out_l, out_c


def _gla_feats(h, q, k, v, lp):
    f32 = jnp.float32
    q = _heads(q).astype(f32) * HEAD_DIM ** -0.5
    k = _heads(k).astype(f32)
    v = _heads(v).astype(f32)
    dirs = []
    for dr in range(2):
        z = (h @ lp['gla_wa1'][dr]) @ lp['gla_wa2'][dr] + lp['gla_ba'][dr]
        log_a = _heads(jax.nn.log_sigmoid(z.astype(f32)) / GLA_NORMALIZER)
        dirs.append((q, k, v, log_a))
    return dirs


def _ret_feats(q, k, v, rope):
    f32 = jnp.float32
    q = _heads(q).astype(f32)
    k = _heads(k).astype(f32) * HEAD_DIM ** -0.5
    v = _heads(v).astype(f32)
    if rope is not None:
        q = _rope(q, *rope)
        k = _rope(k, *rope)
    return [(q, k, v, _ret_log_decay(dr)) for dr in range(2)]


def _rwkv_feats(h, r, k, v, lp):
    f32 = jnp.float32
    B, T, _ = h.shape
    shp = (B, T, HEADS, HEAD_DIM)
    r, k, v = jnp.split(_dwconv3(jnp.concatenate([r, k, v], axis=-1), lp['rwkv_conv']), 3, axis=-1)
    prev, nxt = _neighbours(h)
    xx = 0.5 * (prev + nxt) - h
    xw = h + xx * lp['rwkv_mu'][0]
    xa = h + xx * lp['rwkv_mu'][1]
    xg = h + xx * lp['rwkv_mu'][2]
    g = jax.nn.sigmoid(xg @ lp['rwkv_g1']) @ lp['rwkv_g2']
    kk = (k * lp['rwkv_kk']).astype(f32).reshape(shp)
    kk = kk * lax.rsqrt(jnp.sum(kk * kk, axis=-1, keepdims=True) + EPS)
    r4 = r.astype(f32).reshape(shp)
    v4 = v.astype(f32).reshape(shp)
    rk = lp['rwkv_rk'].reshape(HEADS, HEAD_DIM)
    dirs = []
    bonus = 0.0
    for dr in range(2):
        w_raw = -jax.nn.softplus(-(lp['rwkv_w0'][dr] + jnp.tanh(xw @ lp['rwkv_w1'][dr]) @ lp['rwkv_w2'][dr])) - 0.5
        decay = jnp.exp(-jnp.exp(w_raw.astype(f32))).reshape(shp)
        a = jax.nn.sigmoid(lp['rwkv_a0'][dr] + (xa @ lp['rwkv_a1'][dr]) @ lp['rwkv_a2'][dr]).astype(f32)
        kd = (k.astype(f32) * (1.0 + (a - 1.0) * lp['rwkv_ka'])).reshape(shp)
        a4 = a.reshape(shp)
        dirs.append((r4, decay, kd, v4, -kk, kk * a4))
        bonus = bonus + jnp.sum(r4 * kd * rk, axis=-1, keepdims=True) * v4
    return dirs, bonus, g


def _fourier(f):
    B, T, _ = f.shape
    fg = f.astype(jnp.float32).reshape(B, T, HEADS, HEAD_DIM)
    return jnp.real(jnp.fft.fft2(fg, axes=(1, 3), norm='ortho')).reshape(B, T, BR_W)


def _branch_outputs(parts, o_gla, o_ret, y_rwkv, bonus, g_rwkv, lp):
    f32 = jnp.float32
    dt = parts[0].dtype
    B, T, _ = parts[0].shape
    gla = _head_norm(_unheads(o_gla), lp['gla_gn'], False) * jax.nn.silu(parts[3].astype(f32))
    ret = _head_norm(_unheads(o_ret), lp['ret_gn'], True) * jax.nn.silu(parts[7].astype(f32))
    rwkv = (_head_norm(y_rwkv, lp['rwkv_gn'], True) + bonus.reshape(B, T, BR_W)) * g_rwkv.astype(f32)
    fnet = _fourier(parts[11])
    return [t.astype(dt) for t in (gla, ret, rwkv, fnet)]


def _merge(h, outs, lp):
    z = 0.0
    for i in range(N_BRANCH):
        gate = jax.nn.sigmoid(h @ lp['w_gate'][i] + lp['b_gate'][i])
        z = z + gate * (outs[i] @ lp['w_br'][i])
    return z @ lp['w_out']


def _hybrid_mixer(h, hc, lp, rope, need_ctx):
    pl = jnp.split(h @ lp['w_in'], N_PARTS, axis=-1)
    pc = jnp.split(hc @ lp['w_in'], N_PARTS, axis=-1)
    o_gla, o_gla_c = _bidir(_gla_scan, _gla_feats(h, pl[0], pl[1], pl[2], lp),
                            _gla_feats(hc, pc[0], pc[1], pc[2], lp))
    o_ret, o_ret_c = _bidir(_ret_scan, _ret_feats(pl[4], pl[5], pl[6], rope),
                            _ret_feats(pc[4], pc[5], pc[6], None))
    rl_dirs, rl_bonus, rl_g = _rwkv_feats(h, pl[8], pl[9], pl[10], lp)
    rc_dirs, rc_bonus, rc_g = _rwkv_feats(hc, pc[8], pc[9], pc[10], lp)
    y_rwkv, y_rwkv_c = _bidir(_rwkv_scan, rl_dirs, rc_dirs)
    y = _merge(h, _branch_outputs(pl, o_gla, o_ret, y_rwkv, rl_bonus, rl_g, lp), lp)
    if not need_ctx:
        return y, None
    yc = _merge(hc, _branch_outputs(pc, o_gla_c, o_ret_c, y_rwkv_c, rc_bonus, rc_g, lp), lp)
    return y, yc


def _conv_ffn(h, lp):
    a, u = jnp.split(h @ lp['ffn_up'], 2, axis=-1)
    a = _dwconv3(a, lp['ffn_conv']) + lp['ffn_conv_b']
    return (jax.nn.silu(a) * u) @ lp['ffn_down']


def _modulation(cvec, w, b):
    return jnp.split(jax.nn.silu(cvec) @ w + b, 6, axis=-1)


def setup_inputs(seed: int = 0) -> dict:
    key = jax.random.key(seed)
    keys = jax.random.split(key, 40)
    L, D, F = DEPTH, D_MODEL, D_FF
    f32 = jnp.float32

    def nrm(i, shape, scale):
        return jax.random.normal(keys[i], shape, f32) * scale

    def gain(i, shape):
        return 1.0 + nrm(i, shape, 0.02)

    conv_base = jnp.array([0.25, 0.5, 0.25], f32)[None, :, None]
    return {
        'x': nrm(0, (BATCH, SEQ, D), 1.0),
        'c': nrm(1, (BATCH, D), 1.0),
        'ctx': nrm(2, (BATCH, CTX_LEN, D), 1.0),
        'c_ctx': nrm(3, (D,), 1.0),
        'w_ada': nrm(4, (L, D, 6 * D), 0.5 * D ** -0.5),
        'b_ada': nrm(5, (L, 6 * D), 0.01),
        'g_norm1': gain(6, (L, D)),
        'g_norm2': gain(7, (L, D)),
        'w_in': nrm(8, (L, D, P_IN), D ** -0.5),
        'gla_wa1': nrm(9, (L, 2, D, GLA_LR), D ** -0.5),
        'gla_wa2': nrm(10, (L, 2, GLA_LR, BR_W), GLA_LR ** -0.5),
        'gla_ba': nrm(11, (L, 2, BR_W), 0.5),
        'gla_gn': gain(12, (L, BR_W)),
        'ret_gn': gain(13, (L, BR_W)),
        'rwkv_conv': conv_base + nrm(14, (L, 3, 3 * BR_W), 0.05),
        'rwkv_mu': jax.random.uniform(keys[15], (L, 3, D), f32),
        'rwkv_w0': nrm(16, (L, 2, BR_W), 1.0),
        'rwkv_w1': nrm(17, (L, 2, D, RWKV_DECAY_LR), D ** -0.5),
        'rwkv_w2': nrm(18, (L, 2, RWKV_DECAY_LR, BR_W), 0.5 * RWKV_DECAY_LR ** -0.5),
        'rwkv_a0': nrm(19, (L, 2, BR_W), 0.5),
        'rwkv_a1': nrm(20, (L, 2, D, RWKV_A_LR), D ** -0.5),
        'rwkv_a2': nrm(21, (L, 2, RWKV_A_LR, BR_W), 0.5 * RWKV_A_LR ** -0.5),
        'rwkv_g1': nrm(22, (L, D, RWKV_G_LR), D ** -0.5),
        'rwkv_g2': nrm(23, (L, RWKV_G_LR, BR_W), RWKV_G_LR ** -0.5),
        'rwkv_kk': 0.85 + nrm(24, (L, BR_W), 0.05),
        'rwkv_ka': gain(25, (L, BR_W)),
        'rwkv_rk': nrm(26, (L, BR_W), 0.1),
        'rwkv_gn': gain(27, (L, BR_W)),
        'w_gate': nrm(28, (L, N_BRANCH, D, D), D ** -0.5),
        'b_gate': nrm(29, (L, N_BRANCH, D), 0.01),
        'w_br': nrm(30, (L, N_BRANCH, BR_W, D), BR_W ** -0.5),
        'w_out': nrm(31, (L, D, D), D ** -0.5),
        'ffn_up': nrm(32, (L, D, 2 * F), D ** -0.5),
        'ffn_conv': conv_base + nrm(33, (L, 3, F), 0.05),
        'ffn_conv_b': nrm(34, (L, F), 0.01),
        'ffn_down': nrm(35, (L, F, D), F ** -0.5),
        'g_final': gain(36, (D,)),
    }


def reference(x, c, ctx, c_ctx, w_ada, b_ada, g_norm1, g_norm2, w_in, gla_wa1, gla_wa2, gla_ba,
              gla_gn, ret_gn, rwkv_conv, rwkv_mu, rwkv_w0, rwkv_w1, rwkv_w2, rwkv_a0, rwkv_a1,
              rwkv_a2, rwkv_g1, rwkv_g2, rwkv_kk, rwkv_ka, rwkv_rk, rwkv_gn, w_gate, b_gate, w_br,
              w_out, ffn_up, ffn_conv, ffn_conv_b, ffn_down, g_final):
    rope = _axial_rope(x.shape[1])
    for l in range(DEPTH):
        last = l == DEPTH - 1
        lp = {
            'w_in': w_in[l], 'gla_wa1': gla_wa1[l], 'gla_wa2': gla_wa2[l], 'gla_ba': gla_ba[l],
            'gla_gn': gla_gn[l], 'ret_gn': ret_gn[l], 'rwkv_conv': rwkv_conv[l], 'rwkv_mu': rwkv_mu[l],
            'rwkv_w0': rwkv_w0[l], 'rwkv_w1': rwkv_w1[l], 'rwkv_w2': rwkv_w2[l],
            'rwkv_a0': rwkv_a0[l], 'rwkv_a1': rwkv_a1[l], 'rwkv_a2': rwkv_a2[l],
            'rwkv_g1': rwkv_g1[l], 'rwkv_g2': rwkv_g2[l], 'rwkv_kk': rwkv_kk[l],
            'rwkv_ka': rwkv_ka[l], 'rwkv_rk': rwkv_rk[l], 'rwkv_gn': rwkv_gn[l],
            'w_gate': w_gate[l], 'b_gate': b_gate[l], 'w_br': w_br[l], 'w_out': w_out[l],
            'ffn_up': ffn_up[l], 'ffn_conv': ffn_conv[l], 'ffn_conv_b': ffn_conv_b[l],
            'ffn_down': ffn_down[l],
        }
        m = [t[:, None, :] for t in _modulation(c, w_ada[l], b_ada[l])]
        mc = _modulation(c_ctx, w_ada[l], b_ada[l])
        h = _rmsnorm(x, g_norm1[l]) * (1.0 + m[1]) + m[0]
        hc = _rmsnorm(ctx, g_norm1[l]) * (1.0 + mc[1]) + mc[0]
        y, yc = _hybrid_mixer(h, hc, lp, rope, not last)
        x = x + m[2] * y
        x = x + m[5] * _conv_ffn(_rmsnorm(x, g_norm2[l]) * (1.0 + m[4]) + m[3], lp)
        if not last:
            ctx = ctx + mc[2] * yc
            ctx = ctx + mc[5] * _conv_ffn(_rmsnorm(ctx, g_norm2[l]) * (1.0 + mc[4]) + mc[3], lp)
    return _rmsnorm(x, g_final)
```

```cpp
#include <hip/hip_runtime.h>
#include <hip/hip_cooperative_groups.h>
#include <cstdio>
namespace cg = cooperative_groups;

#ifndef USE_COOP
#define USE_COOP 1
#endif

#define LAS __attribute__((address_space(3)))
typedef unsigned short bf16_t;
typedef short bf16x8 __attribute__((ext_vector_type(8)));
typedef float f32x4 __attribute__((ext_vector_type(4)));
typedef unsigned u32x4 __attribute__((ext_vector_type(4)));
typedef unsigned u32x2 __attribute__((ext_vector_type(2)));

constexpr int DM = 1024, NBATCH = 8, TL = 4096, TC = 256, NLAYER = 2;
constexpr int NHB = 4;
constexpr int RLH = NHB * TL;
constexpr int RCH = NHB * TC;
constexpr int RH = RLH + RCH;
constexpr int N1 = 4352, NMAIN = 2816, NAUX = 1536, K2 = 512, N2 = 1792, DFF = 2816;
constexpr float EPSF = 1e-6f;
constexpr int NWG_SCAN = 192;

constexpr size_t al256(size_t x) { return (x + 255) & ~(size_t)255; }
constexpr size_t WS_W1T = 0;
constexpr size_t WS_WGT = WS_W1T + (size_t)N1 * 1024 * 2;
constexpr size_t WS_W2T = WS_WGT + (size_t)4096 * 1024 * 2;
constexpr size_t WS_WBRT = WS_W2T + (size_t)N2 * K2 * 2;
constexpr size_t WS_WOUTT = WS_WBRT + (size_t)4 * 1024 * 256 * 2;
constexpr size_t WS_WUPT = WS_WOUTT + (size_t)1024 * 1024 * 2;
constexpr size_t WS_WDNT = WS_WUPT + (size_t)5632 * 1024 * 2;
constexpr size_t WS_CMAT = WS_WDNT + (size_t)1024 * 2816 * 2;
constexpr size_t WS_SMAT = WS_CMAT + (size_t)2048 * 2048 * 2;
constexpr size_t WS_MODP = WS_SMAT + (size_t)2048 * 2048 * 2;
constexpr size_t WS_MOD = WS_MODP + (size_t)16 * 2 * 9 * 6144 * 4;
constexpr size_t WS_ROPE = WS_MOD + (size_t)2 * 9 * 6144 * 4;
constexpr size_t WS_XCTX = WS_ROPE + (size_t)4096 * 32 * 2 * 4;
constexpr size_t WS_GR2048 = WS_XCTX + (size_t)2048 * 1024 * 4;
constexpr size_t WS_GC = WS_GR2048 + (size_t)4 * 256 * 4;
constexpr size_t WS_NYQP = WS_GC + (size_t)4 * 256 * 512 * 2;
constexpr size_t WS_ERT = WS_NYQP + (size_t)4 * 32 * 256 * 4;
constexpr size_t WS_OIT = WS_ERT + (size_t)1024 * 2048 * 2;
constexpr size_t WS_FC = WS_OIT + (size_t)1024 * 2048 * 2;
constexpr size_t WS_FS = WS_FC + (size_t)2048 * 1024 * 4;
constexpr size_t WS_HB = WS_FS + (size_t)2048 * 1024 * 4;
constexpr size_t WS_BIG = WS_HB + (size_t)RH * 1024 * 2;
constexpr size_t ARR2 = (size_t)RH * 256 * 2, ARR4 = (size_t)RH * 256 * 4;
constexpr size_t WS_PMAIN = WS_BIG;
constexpr size_t WS_PRE2 = WS_PMAIN + (size_t)RH * NMAIN * 2;
constexpr size_t WS_SCIN = WS_PRE2 + (size_t)RH * N2 * 2;
constexpr size_t WS_PAUX = WS_SCIN;
constexpr size_t WS_A2 = WS_PAUX + (size_t)RH * NAUX * 2;
constexpr size_t WS_RW_R = WS_SCIN, WS_RW_V = WS_RW_R + ARR2, WS_RW_NKK = WS_RW_V + ARR2, WS_RW_B = WS_RW_NKK + ARR2  ,
                 WS_RW_KD = WS_RW_B + 2 * ARR2  , WS_RW_W = WS_RW_KD + 2 * ARR2  , WS_GA = WS_RW_W + 2 * ARR4  ,
                 WS_GRW = WS_GA + 2 * ARR4, WS_BONUS = WS_GRW + ARR2, WS_SCIN_END = WS_BONUS + ARR4;
constexpr size_t WS_SO = WS_PRE2;
constexpr size_t WS_OUTS = WS_SCIN;
constexpr size_t WS_Z = WS_OUTS + (size_t)RH * 1024 * 2;
constexpr size_t WS_GBUF = WS_PMAIN;
constexpr size_t WS_U = WS_PMAIN;
constexpr size_t WS_ACT = WS_U + (size_t)RH * 5632 * 2;
constexpr size_t WS_END = (WS_SCIN_END > WS_ACT + (size_t)RH * 2816 * 2) ? WS_SCIN_END : WS_ACT + (size_t)RH * 2816 * 2;
static_assert(6 * ARR2 <= (size_t)RH * N2 * 2, "scan outs fit PRE2");
static_assert(WS_Z + (size_t)RH * 1024 * 2 <= WS_GRW, "outs+z inside dead scan inputs");
static_assert(WS_GBUF + (size_t)RH * 4096 * 2 <= WS_SCIN, "gbuf fits");
static_assert(WS_A2 + (size_t)RH * K2 * 2 <= WS_SCIN_END, "a2 fits");

constexpr int LDS_BYTES = 131072 + 8192;

struct KArgs {
    const float* in[37];
    float* out;
    unsigned char* ws;
    int step_lo, step_hi;
};
struct Params { float* out; unsigned char* ws; };

extern __shared__ __attribute__((aligned(16))) unsigned char g_shm[];
#define IN(k) (((const float* const*)(g_shm + 131072))[k])

__device__ __forceinline__ int get_tid() { int t = threadIdx.x; asm volatile("" : "+v"(t)); return t; }
__device__ __forceinline__ float bf2f(bf16_t b) { return __uint_as_float(((unsigned)b) << 16); }
__device__ __forceinline__ bf16_t f2bf(float f) { unsigned u = __float_as_uint(f); u += 0x7FFFu + ((u >> 16) & 1u); return (bf16_t)(u >> 16); }
__device__ __forceinline__ unsigned cvt_pk_bf16(float lo, float hi) { unsigned r; asm volatile("v_cvt_pk_bf16_f32 %0, %1, %2" : "=v"(r) : "v"(lo), "v"(hi)); return r; }
__device__ __forceinline__ float sigmoidf_(float x) { return __builtin_amdgcn_rcpf(1.0f + __expf(-x)); }
__device__ __forceinline__ float siluf_(float x) { return x * sigmoidf_(x); }
__device__ __forceinline__ float softplusf_(float x) { return fmaxf(x, 0.f) + log1pf(__expf(-fabsf(x))); }
__device__ __forceinline__ float wave_sum(float v) {
#pragma unroll
    for (int o = 32; o > 0; o >>= 1) v += __shfl_xor(v, o, 64);
    return v;
}
template <int CTRL> __device__ __forceinline__ float dpp_f(float x) { return __int_as_float(__builtin_amdgcn_update_dpp(0, __float_as_int(x), CTRL, 0xF, 0xF, false)); }
__device__ __forceinline__ float row16_allsum(float x) {
    x += dpp_f<0x128>(x); x += dpp_f<0x124>(x); x += dpp_f<0x122>(x); x += dpp_f<0x121>(x); return x;
}
__device__ __forceinline__ void rowinfo(int r, int& isctx, int& bl, int& t) {
    if (r < RLH) { isctx = 0; bl = r >> 12; t = r & 4095; } else { const int rc = r - RLH; isctx = 1; bl = rc >> 8; t = rc & 255; }
}
__device__ __forceinline__ float* xrow_ptr(const Params& p, int half, int r) {
    int isctx, bl, t; rowinfo(r, isctx, bl, t); const int b = half * NHB + bl;
    return isctx ? ((float*)(p.ws + WS_XCTX) + ((size_t)b * TC + t) * DM) : (p.out + ((size_t)b * TL + t) * DM);
}

constexpr int BM = 256, BN = 128, BK = 64, HTB = 128 * BK * 2, STG = 3 * HTB, NXCD = 8, WGM = 8;
__device__ __forceinline__ int lds_byte(int r, int c) { const int st = (r >> 4) * 2 + (c >> 5), rr = r & 15, cc = c & 31, ob = rr * 64 + cc * 2; return st * 1024 + (ob ^ (((ob >> 9) & 1) << 5)); }
__device__ __forceinline__ void stage_rc(int b, int& R, int& C) { const int st = b / 1024, sb = b % 1024, swz = sb ^ (((sb >> 9) & 1) << 5); R = (st >> 1) * 16 + swz / 64; C = (st & 1) * 32 + (swz % 64) / 2; }
__device__ __forceinline__ int perm32(int rho) { const int n = rho >> 4, i = rho & 15; return 8 * (i >> 2) + 4 * n + (i & 3); }

struct Unit { int pm, pn, seg; };
struct Sched {
    int nM, nN, nseg, ntiles, G, c;
    __device__ void init(int M, int N, int nseg_, int G_, int c_) { nM = M / BM; nN = N / BN; nseg = nseg_; ntiles = nM * nN; G = G_; c = c_; }
    __device__ bool next(int i, Unit& u) const {
        const int ti = i / nseg; const long L = (long)ti * G + c; if (L >= ntiles) return false;
        u.seg = i - ti * nseg;
        int wgid = (int)L; { const int q = ntiles / NXCD, r = ntiles % NXCD, xcd = wgid % NXCD, off = wgid / NXCD; wgid = (xcd < r ? xcd * (q + 1) : r * (q + 1) + (xcd - r) * q) + off; }
        const int nig = WGM * nN, gid = wgid / nig, fm = gid * WGM, gsz = (nM - fm) < WGM ? (nM - fm) : WGM;
        u.pm = fm + ((wgid % nig) % gsz); u.pn = (wgid % nig) / gsz; return true;
    }
};
struct Prob {
    const bf16_t* A; const bf16_t* Bt; int lda, ldb, nt; size_t a_seg, b_seg;
    __device__ __forceinline__ void ptrs(const Unit& u, const char*& a, const char*& b) const {
        a = (const char*)(A + (size_t)u.pm * BM * lda + (size_t)u.seg * a_seg);
        b = (const char*)(Bt + (size_t)u.pn * BN * ldb + (size_t)u.seg * b_seg);
    }
};

typedef f32x4 Acc[4][4];
__device__ __forceinline__ void acc_zero(Acc& acc) {
#pragma unroll
    for (int m = 0; m < 4; ++m)
#pragma unroll
        for (int n = 0; n < 4; ++n) acc[m][n] = (f32x4){0.f, 0.f, 0.f, 0.f};
}
struct EpiU;
__device__ __forceinline__ void epi_apply(const EpiU& E, int mode, const Acc& acc, const Unit& u, int wr, int wc, int fr, int fq);
__device__ __forceinline__ void epi_rescale(const EpiU& E, Acc& acc, const Unit& u, int wr, int wc, int fr, int fq);
__device__ __forceinline__ int epi_mode(const EpiU& E);

__device__ __forceinline__ void gemm_phase(LAS unsigned char* lds, const Prob P, const Sched& S, const EpiU& E) {
    const int tid = get_tid(), wid = __builtin_amdgcn_readfirstlane(tid >> 6), lane = tid & 63, wr = wid >> 1, wc = wid & 1, fr = lane & 15, fq = lane >> 4;
    const int nt = P.nt; const int mode = epi_mode(E); const bool perm = mode < 4;
    unsigned voffA[2], voffB[2];
#pragma unroll
    for (int i = 0; i < 2; ++i) { int R, C; stage_rc(tid * 16 + i * 8192, R, C); const int Rb = perm ? ((R & ~31) + perm32(R & 31)) : R;
        voffA[i] = (unsigned)(R * P.lda + C) * 2u; voffB[i] = (unsigned)(Rb * P.ldb + C) * 2u; }
    const size_t kstep = (size_t)(BK * 2), hstepA = (size_t)128 * P.lda * 2;
    const unsigned ldsw = (unsigned)wid * 1024u;
    const int aoff = (wr >> 1) * HTB + lds_byte((wr & 1) * 64 + fr, fq * 8), boff = 2 * HTB + lds_byte(wc * 64 + fr, fq * 8);
#define G_STAGE1(bufoff, gbase, voff) do { _Pragma("unroll") for (int _i = 0; _i < 2; ++_i) \
        __builtin_amdgcn_global_load_lds((const unsigned*)((const char*)(gbase) + (voff)[_i]), (LAS unsigned*)(lds + (bufoff) + ldsw + _i * 8192), 16, 0, 0); } while (0)
#define G_STAGE(s, ga, gb) do { G_STAGE1((s) * STG, ga, voffA); G_STAGE1((s) * STG + HTB, (ga) + hstepA, voffA); G_STAGE1((s) * STG + 2 * HTB, gb, voffB); } while (0)
#define G_WAIT_V(n) asm volatile("s_waitcnt vmcnt(" #n ")" ::: "memory")
#define G_BAR do { asm volatile("" ::: "memory"); __builtin_amdgcn_s_barrier(); asm volatile("" ::: "memory"); } while (0)
    Unit cur, nxt; int ui = 0;
    if (!S.next(0, cur)) return;
    Acc acc; acc_zero(acc);
    const char* cA; const char* cB; P.ptrs(cur, cA, cB);
    G_STAGE(0, cA, cB);
    for (;;) {
        const bool has_next = S.next(ui + 1, nxt);
        const char* nA = cA; const char* nB = cB; if (has_next) P.ptrs(nxt, nA, nB);
        for (int t = 0; t < nt; ++t) {
            const int s = t & 1;
            if (t + 1 < nt) { G_STAGE(s ^ 1, cA + (size_t)(t + 1) * kstep, cB + (size_t)(t + 1) * kstep); G_WAIT_V(6); }
            else if (has_next) { G_STAGE(s ^ 1, nA, nB); G_WAIT_V(6); }
            else { G_WAIT_V(0); }
            G_BAR;
            bf16x8 Af[4][2], Bf[4][2];
#pragma unroll
            for (int m = 0; m < 4; ++m)
#pragma unroll
                for (int k = 0; k < 2; ++k) Af[m][k] = *(const LAS bf16x8*)(lds + s * STG + aoff + m * 2048 + k * 1024);
#pragma unroll
            for (int n = 0; n < 4; ++n)
#pragma unroll
                for (int k = 0; k < 2; ++k) Bf[n][k] = *(const LAS bf16x8*)(lds + s * STG + boff + n * 2048 + k * 1024);
#pragma unroll
            for (int k = 0; k < 2; ++k)
#pragma unroll
                for (int m = 0; m < 4; ++m)
#pragma unroll
                    for (int n = 0; n < 4; ++n) acc[m][n] = __builtin_amdgcn_mfma_f32_16x16x32_bf16(Bf[n][k], Af[m][k], acc[m][n], 0, 0, 0);
            asm volatile("s_waitcnt lgkmcnt(0)" ::: "memory");
            G_BAR;
        }
        epi_apply(E, mode, acc, cur, wr, wc, fr, fq);
        if (mode == 3 && cur.seg < 3) epi_rescale(E, acc, cur, wr, wc, fr, fq); else acc_zero(acc);
        if (!has_next) break;
        cur = nxt; cA = nA; cB = nB; ++ui;
    }
    G_BAR;
#undef G_STAGE1
#undef G_STAGE
#undef G_WAIT_V
#undef G_BAR
}

__device__ __forceinline__ void unpack8(const u32x4 gc, float* g) {
    g[0] = __uint_as_float(gc.x << 16); g[1] = __uint_as_float(gc.x & 0xFFFF0000u); g[2] = __uint_as_float(gc.y << 16); g[3] = __uint_as_float(gc.y & 0xFFFF0000u);
    g[4] = __uint_as_float(gc.z << 16); g[5] = __uint_as_float(gc.z & 0xFFFF0000u); g[6] = __uint_as_float(gc.w << 16); g[7] = __uint_as_float(gc.w & 0xFFFF0000u);
}
struct EpiU {
    int mode;
    void* O; void* O2; int ldc; const float* bias; float* xlat; float* xctx; int half; const float* modl; int gidx; size_t seg_stride;
};
__device__ __forceinline__ int epi_mode(const EpiU& E) { return E.mode; }
__device__ __forceinline__ void epi_rescale(const EpiU& E, Acc& acc, const Unit& u, int wr, int wc, int fr, int fq) {
    const bf16_t* G = (const bf16_t*)E.O2; const int row0 = u.pm * BM + wr * 64 + fr, col0 = u.pn * BN + wc * 64 + 8 * fq, seg = u.seg;
#pragma unroll
    for (int m = 0; m < 4; ++m) { const size_t r = (size_t)(row0 + m * 16);
#pragma unroll
        for (int g2 = 0; g2 < 2; ++g2) { float g[8], h[8]; unpack8(*(const u32x4*)(G + r * 4096 + seg * 1024 + col0 + g2 * 32), g); unpack8(*(const u32x4*)(G + r * 4096 + (seg + 1) * 1024 + col0 + g2 * 32), h);
#pragma unroll
            for (int j = 0; j < 4; ++j) { acc[m][2 * g2][j] *= g[j] * __builtin_amdgcn_rcpf(h[j]); acc[m][2 * g2 + 1][j] *= g[4 + j] * __builtin_amdgcn_rcpf(h[4 + j]); } } }
}
__device__ __forceinline__ void epi_apply(const EpiU& E, int mode, const Acc& acc, const Unit& u, int wr, int wc, int fr, int fq) {
    const int row0 = u.pm * BM + wr * 64 + fr;
    if (mode < 4) {
        if (mode == 3 && u.seg != 3) return;
        bf16_t* base = (bf16_t*)E.O; int ld = E.ldc, colt = u.pn * BN;
        if (mode == 0) { if (u.pn < 22) { ld = NMAIN; } else { base = (bf16_t*)E.O2; ld = NAUX; colt = (u.pn - 22) * BN; } }
        if (mode == 3) ld = 1024;
        const int col0 = colt + wc * 64 + 8 * fq, gcol0 = u.pn * BN + wc * 64 + 8 * fq;
#pragma unroll
        for (int m = 0; m < 4; ++m) { const size_t r = (size_t)(row0 + m * 16);
#pragma unroll
            for (int g2 = 0; g2 < 2; ++g2) { f32x4 v0 = acc[m][2 * g2], v1 = acc[m][2 * g2 + 1];
                if (mode == 2) { const f32x4 b0 = *(const f32x4*)(E.bias + gcol0 + g2 * 32), b1 = *(const f32x4*)(E.bias + gcol0 + g2 * 32 + 4);
#pragma unroll
                    for (int j = 0; j < 4; ++j) { v0[j] = fmaxf(sigmoidf_(v0[j] + b0[j]), 1e-30f); v1[j] = fmaxf(sigmoidf_(v1[j] + b1[j]), 1e-30f); } }
                if (mode == 3) { float g[8]; unpack8(*(const u32x4*)((const bf16_t*)E.O2 + r * 4096 + 3 * 1024 + gcol0 + g2 * 32), g);
#pragma unroll
                    for (int j = 0; j < 4; ++j) { v0[j] *= g[j]; v1[j] *= g[4 + j]; } }
                u32x4 w; w.x = cvt_pk_bf16(v0[0], v0[1]); w.y = cvt_pk_bf16(v0[2], v0[3]); w.z = cvt_pk_bf16(v1[0], v1[1]); w.w = cvt_pk_bf16(v1[2], v1[3]);
                *(u32x4*)(base + r * ld + col0 + g2 * 32) = w; } }
    } else if (mode == 4) {
        const int pm = u.pm; int bl, isctx; if (pm < 64) { isctx = 0; bl = pm >> 4; } else { isctx = 1; bl = pm - 64; }
        const int b = E.half * NHB + bl; const int mb = isctx ? 8 : b;
        const float* mv = E.modl + (size_t)mb * 6144 + E.gidx * 1024;
        float* xb = isctx ? (E.xctx + (size_t)b * TC * DM) : (E.xlat + ((size_t)b * TL + (size_t)(pm & 15) * BM) * DM);
        const int lrow0 = wr * 64 + fr, col0 = u.pn * BN + wc * 64 + 4 * fq;
#pragma unroll
        for (int n = 0; n < 4; ++n) { const f32x4 mm = *(const f32x4*)(mv + col0 + n * 16);
#pragma unroll
            for (int m = 0; m < 4; ++m) { f32x4* q = (f32x4*)(xb + (size_t)(lrow0 + m * 16) * DM + col0 + n * 16); *q = *q + mm * acc[m][n]; } }
    } else {
        float* base = (float*)E.O + (size_t)u.seg * E.seg_stride; const int col0 = u.pn * BN + wc * 64 + 4 * fq;
#pragma unroll
        for (int m = 0; m < 4; ++m)
#pragma unroll
            for (int n = 0; n < 4; ++n) *(f32x4*)(base + (size_t)(row0 + m * 16) * E.ldc + col0 + n * 16) = acc[m][n];
    }
}

__device__ void ph_setup(const Params& p, float* shf) {
    const size_t gt = (size_t)blockIdx.x * 512 + get_tid(), gn = (size_t)gridDim.x * 512;
    { const f32x4* s = (const f32x4*)IN(0); f32x4* d = (f32x4*)p.out; const size_t n = (size_t)NBATCH * TL * DM / 4; for (size_t i = gt; i < n; i += gn) d[i] = s[i]; }
    { const f32x4* s = (const f32x4*)IN(2); f32x4* d = (f32x4*)(p.ws + WS_XCTX); const size_t n = (size_t)NBATCH * TC * DM / 4; for (size_t i = gt; i < n; i += gn) d[i] = s[i]; }
    { float* modp = (float*)(p.ws + WS_MODP); const float* c = IN(1); const float* cc = IN(3); const float* wa = IN(4);
      const size_t items = (size_t)16 * 2 * 6144;
      for (size_t it = gt; it < items; it += gn) { const int n = (int)(it % 6144); const int l = (int)((it / 6144) & 1); const int kc = (int)(it / (6144 * 2));
          float a[9]; for (int j = 0; j < 9; ++j) a[j] = 0.f;
          for (int k = kc * 64; k < kc * 64 + 64; ++k) { const float w = wa[((size_t)l * 1024 + k) * 6144 + n];
#pragma unroll
              for (int j = 0; j < 8; ++j) a[j] += siluf_(c[j * 1024 + k]) * w;
              a[8] += siluf_(cc[k]) * w; }
          for (int j = 0; j < 9; ++j) modp[(((size_t)kc * 2 + l) * 9 + j) * 6144 + n] = a[j]; } }
    { float* rc = (float*)(p.ws + WS_ROPE); float* rs = rc + 4096 * 32;
      for (size_t i = gt; i < (size_t)4096 * 32; i += gn) { const int t = (int)(i >> 5), j = (int)(i & 31); const float inv = powf(10000.0f, -(float)(j & 15) / 16.0f);
          const float pos = (j < 16) ? (float)(t >> 6) : (float)(t & 63); const float ang = pos * inv; float s, c2; sincosf(ang, &s, &c2); rc[i] = c2; rs[i] = s; } }
    { bf16_t* cm = (bf16_t*)(p.ws + WS_CMAT); bf16_t* sm = (bf16_t*)(p.ws + WS_SMAT);
      for (size_t i = gt; i < (size_t)2048 * 2048; i += gn) { const int tp = (int)(i >> 11), k = (int)(i & 2047); const int m = (tp * k) & 4095; float s, c2; sincospif((float)m * (1.0f / 2048.0f), &s, &c2);
          cm[i] = f2bf(c2); sm[i] = f2bf(s); } }
}
__device__ void ph_modreduce(const Params& p) {
    const size_t gt = (size_t)blockIdx.x * 512 + get_tid(), gn = (size_t)gridDim.x * 512;
    const float* modp = (const float*)(p.ws + WS_MODP); float* mod = (float*)(p.ws + WS_MOD); const float* ba = IN(5);
    for (size_t i = gt; i < (size_t)2 * 9 * 6144; i += gn) { const int n = (int)(i % 6144); const int l = (int)(i / (9 * 6144));
        float a = ba[(size_t)l * 6144 + n]; for (int kc = 0; kc < 16; ++kc) a += modp[(size_t)kc * 2 * 9 * 6144 + i]; mod[i] = a; }
}
__device__ void tconv(const float* src, int lds_, int K, int N, bf16_t* dst, int ldd, bool win_scale, float* tile) {
    const int tid = get_tid(); const int ntn = N / 64, ntiles = (K / 64) * ntn;
    for (int id = blockIdx.x; id < ntiles; id += gridDim.x) {
        const int k0 = (id / ntn) * 64, n0 = (id % ntn) * 64;
        float sc = 1.0f; if (win_scale && ((n0 < 256) || (n0 >= 1280 && n0 < 1536))) sc = 0.125f;
        { const int j = tid & 63, i0 = tid >> 6;
#pragma unroll
          for (int q = 0; q < 8; ++q) { const int k = i0 + 8 * q; tile[k * 65 + j] = src[(size_t)(k0 + k) * lds_ + n0 + j] * sc; } }
        __syncthreads();
        { const int n = tid >> 3, kk = (tid & 7) * 8; float v[8];
#pragma unroll
          for (int q = 0; q < 8; ++q) v[q] = tile[(kk + q) * 65 + n];
          u32x4 w; w.x = cvt_pk_bf16(v[0], v[1]); w.y = cvt_pk_bf16(v[2], v[3]); w.z = cvt_pk_bf16(v[4], v[5]); w.w = cvt_pk_bf16(v[6], v[7]);
          *(u32x4*)(dst + (size_t)(n0 + n) * ldd + k0 + kk) = w; }
        __syncthreads();
    }
}
__device__ void ph_wconv(const Params& p, int l, float* shf) {
    bf16_t* w1t = (bf16_t*)(p.ws + WS_W1T);
    tconv(IN(8) + (size_t)l * 1024 * 3072, 3072, 1024, 2816, w1t, 1024, true, shf);
    for (int i = 0; i < 4; ++i) tconv(IN(28) + ((size_t)l * 4 + i) * 1024 * 1024, 1024, 1024, 1024, (bf16_t*)(p.ws + WS_WGT) + (size_t)i * 1024 * 1024, 1024, false, shf);
    for (int i = 0; i < 4; ++i) tconv(IN(30) + ((size_t)l * 4 + i) * 256 * 1024, 1024, 256, 1024, (bf16_t*)(p.ws + WS_WBRT) + (size_t)i * 1024 * 256, 256, false, shf);
    tconv(IN(31) + (size_t)l * 1024 * 1024, 1024, 1024, 1024, (bf16_t*)(p.ws + WS_WOUTT), 1024, false, shf);
    tconv(IN(32) + (size_t)l * 1024 * 5632, 5632, 1024, 5632, (bf16_t*)(p.ws + WS_WUPT), 1024, false, shf);
    tconv(IN(35) + (size_t)l * 2816 * 1024, 1024, 2816, 1024, (bf16_t*)(p.ws + WS_WDNT), 2816, false, shf);
    const size_t gt = (size_t)blockIdx.x * 512 + get_tid(), gn = (size_t)gridDim.x * 512;
    const float* win = IN(8) + (size_t)l * 1024 * 3072; const float* mu = IN(15) + (size_t)l * 3 * 1024;
    for (size_t i = gt; i < (size_t)NAUX * 1024; i += gn) {
        const int nn = (int)(i >> 10), k = (int)(i & 1023); float v = 0.f;
        if (nn < 512) { const int ri = nn >> 8, h = (nn >> 6) & 3, cp = nn & 63; const float* wr = win + (size_t)k * 3072 + 2816 + h * 64; float a = 0.f;
            for (int c = 0; c < 64; ++c) { const int m = (c * cp) & 63; float s, c2; sincospif((float)m * (1.0f / 32.0f), &s, &c2); a += wr[c] * (ri ? -s : c2); } v = a; }
        else if (nn < 544) { const int j = nn - 512, dr = j >> 4, jj = j & 15; v = IN(9)[(((size_t)l * 2 + dr) * 1024 + k) * 16 + jj]; }
        else if (nn < 672) { const int j = nn - 544, dr = j >> 6, jj = j & 63; v = IN(17)[(((size_t)l * 2 + dr) * 1024 + k) * 64 + jj]; }
        else if (nn < 800) { const int j = nn - 672, dr = j >> 6, jj = j & 63; v = mu[k] * IN(17)[(((size_t)l * 2 + dr) * 1024 + k) * 64 + jj]; }
        else if (nn < 928) { const int j = nn - 800, dr = j >> 6, jj = j & 63; v = IN(20)[(((size_t)l * 2 + dr) * 1024 + k) * 64 + jj]; }
        else if (nn < 1056) { const int j = nn - 928, dr = j >> 6, jj = j & 63; v = mu[1024 + k] * IN(20)[(((size_t)l * 2 + dr) * 1024 + k) * 64 + jj]; }
        else if (nn < 1216) { const int jj = nn - 1056; v = IN(22)[((size_t)l * 1024 + k) * 160 + jj]; }
        else if (nn < 1376) { const int jj = nn - 1216; v = mu[2048 + k] * IN(22)[((size_t)l * 1024 + k) * 160 + jj]; }
        w1t[(size_t)(2816 + nn) * 1024 + k] = f2bf(v);
    }
    bf16_t* w2t = (bf16_t*)(p.ws + WS_W2T);
    for (size_t i = gt; i < (size_t)N2 * K2; i += gn) {
        const int n = (int)(i >> 9), k = (int)(i & 511); const int grp = n >> 8, c = n & 255; float v = 0.f;
        if (grp < 2) { const int kk = k - 64 * grp; if (kk >= 0 && kk < 64) v = IN(18)[(((size_t)l * 2 + grp) * 64 + kk) * 256 + c]; }
        else if (grp < 4) { const int d = grp - 2, kk = k - 128 - 64 * d; if (kk >= 0 && kk < 64) v = IN(21)[(((size_t)l * 2 + d) * 64 + kk) * 256 + c]; }
        else if (grp == 4) { const int kk = k - 256; if (kk >= 0 && kk < 160) v = IN(23)[((size_t)l * 160 + kk) * 256 + c]; }
        else { const int d = grp - 5, kk = k - 416 - 16 * d; if (kk >= 0 && kk < 16) v = IN(10)[(((size_t)l * 2 + d) * 16 + kk) * 256 + c]; }
        w2t[i] = f2bf(v);
    }
}

__device__ void ph_norm(const Params& p, int l, int half, int which, int nrows) {
    const int wv = get_tid() >> 6, lane = get_tid() & 63;
    const float* g = IN(which ? 7 : 6) + (size_t)l * 1024; const float* modl = (const float*)(p.ws + WS_MOD) + (size_t)l * 9 * 6144;
    bf16_t* hb = (bf16_t*)(p.ws + WS_HB);
    for (int r = blockIdx.x * 8 + wv; r < nrows; r += gridDim.x * 8) {
        int isctx, bl, t; rowinfo(r, isctx, bl, t); const int mb = isctx ? 8 : half * NHB + bl;
        const float* x = xrow_ptr(p, half, r); const float* sh = modl + (size_t)mb * 6144 + (which ? 3 : 0) * 1024; const float* sc = sh + 1024;
        f32x4 v[4]; float ss = 0.f;
#pragma unroll
        for (int q = 0; q < 4; ++q) { v[q] = *(const f32x4*)(x + q * 256 + lane * 4); ss += v[q][0] * v[q][0] + v[q][1] * v[q][1] + v[q][2] * v[q][2] + v[q][3] * v[q][3]; }
        ss = wave_sum(ss); const float rs = rsqrtf(ss * (1.0f / 1024.0f) + EPSF);
#pragma unroll
        for (int q = 0; q < 4; ++q) { const int c = q * 256 + lane * 4; const f32x4 gg = *(const f32x4*)(g + c), s1 = *(const f32x4*)(sc + c), s0 = *(const f32x4*)(sh + c);
            float o[4];
#pragma unroll
            for (int j = 0; j < 4; ++j) o[j] = v[q][j] * rs * gg[j] * (1.0f + s1[j]) + s0[j];
            u32x2 w; w.x = cvt_pk_bf16(o[0], o[1]); w.y = cvt_pk_bf16(o[2], o[3]); *(u32x2*)(hb + (size_t)r * 1024 + c) = w; }
    }
}
__device__ void ph_final(const Params& p) {
    const int wv = get_tid() >> 6, lane = get_tid() & 63; const float* g = IN(36);
    for (int r = blockIdx.x * 8 + wv; r < NBATCH * TL; r += gridDim.x * 8) {
        float* x = p.out + (size_t)r * DM; f32x4 v[4]; float ss = 0.f;
#pragma unroll
        for (int q = 0; q < 4; ++q) { v[q] = *(const f32x4*)(x + q * 256 + lane * 4); ss += v[q][0] * v[q][0] + v[q][1] * v[q][1] + v[q][2] * v[q][2] + v[q][3] * v[q][3]; }
        ss = wave_sum(ss); const float rs = rsqrtf(ss * (1.0f / 1024.0f) + EPSF);
#pragma unroll
        for (int q = 0; q < 4; ++q) { const int c = q * 256 + lane * 4; const f32x4 gg = *(const f32x4*)(g + c); f32x4 o;
#pragma unroll
            for (int j = 0; j < 4; ++j) o[j] = v[q][j] * rs * gg[j];
            *(f32x4*)(x + c) = o; }
    }
}

__device__ void ph_prepA(const Params& p, float* shf) {
    const int tid = get_tid(), wv = tid >> 6, lane = tid & 63;
    const bf16_t* paux = (const bf16_t*)(p.ws + WS_PAUX); bf16_t* a2 = (bf16_t*)(p.ws + WS_A2);
    for (int r = blockIdx.x * 8 + wv; r < RH; r += gridDim.x * 8) {
        int isctx, bl, t; rowinfo(r, isctx, bl, t); const int slen = isctx ? TC : TL; const bool hp = t > 0, hn = t < slen - 1;
        const bf16_t* pc = paux + (size_t)r * NAUX; const bf16_t* pp = pc - NAUX; const bf16_t* pn = pc + NAUX;
#pragma unroll
        for (int q = 0; q < 8; ++q) { const int j = lane + 64 * q; float v = 0.f;
            if (j < 416) { int ph, qm; if (j < 128) { ph = 544 + j; qm = 672 + j; } else if (j < 256) { ph = 800 + (j - 128); qm = 928 + (j - 128); } else { ph = 1056 + (j - 256); qm = 1216 + (j - 256); }
                const float s = bf2f(pc[ph]) + 0.5f * ((hp ? bf2f(pp[qm]) : 0.f) + (hn ? bf2f(pn[qm]) : 0.f)) - bf2f(pc[qm]);
                v = (j < 128) ? tanhf(s) : ((j < 256) ? s : sigmoidf_(s)); }
            else if (j < 448) v = bf2f(pc[512 + (j - 416)]);
            a2[(size_t)r * K2 + j] = f2bf(v); }
    }
    bf16_t* ert = (bf16_t*)(p.ws + WS_ERT); bf16_t* oit = (bf16_t*)(p.ws + WS_OIT);
    for (int id = blockIdx.x; id < 1024; id += gridDim.x) {
        const int kt = id & 31, ntile = (id >> 5) & 3, ri = (id >> 7) & 1, bl = id >> 8; const int k0 = kt * 64, n0 = ntile * 64;
        { const int j = tid & 63, i0 = tid >> 6;
#pragma unroll
          for (int q = 0; q < 8; ++q) { const int i = i0 + 8 * q, k = k0 + i; const float x = bf2f(paux[(size_t)(bl * TL + k) * NAUX + ri * 256 + n0 + j]);
              float xm = 0.f; if (k > 0) xm = bf2f(paux[(size_t)(bl * TL + (4096 - k)) * NAUX + ri * 256 + n0 + j]);
              shf[i * 65 + j] = ri ? (x - xm) : (x + xm); } }
        __syncthreads();
        { const int n = tid >> 3, kk = (tid & 7) * 8; float v[8];
#pragma unroll
          for (int q = 0; q < 8; ++q) v[q] = shf[(kk + q) * 65 + n];
          u32x4 w; w.x = cvt_pk_bf16(v[0], v[1]); w.y = cvt_pk_bf16(v[2], v[3]); w.z = cvt_pk_bf16(v[4], v[5]); w.w = cvt_pk_bf16(v[6], v[7]);
          *(u32x4*)((ri ? oit : ert) + (size_t)(bl * 256 + n0 + n) * 2048 + k0 + kk) = w; }
        __syncthreads();
    }
    const size_t gt = (size_t)blockIdx.x * 512 + tid, gn = (size_t)gridDim.x * 512;
    { bf16_t* gc = (bf16_t*)(p.ws + WS_GC); for (size_t i = gt; i < (size_t)RCH * 512; i += gn) { const int rc = (int)(i >> 9), c = (int)(i & 511); gc[i] = paux[(size_t)(RLH + rc) * NAUX + c]; } }
    { float* g2 = (float*)(p.ws + WS_GR2048); for (size_t i = gt; i < (size_t)NHB * 256; i += gn) { const int bl = (int)(i >> 8), n = (int)(i & 255); g2[i] = bf2f(paux[(size_t)(bl * TL + 2048) * NAUX + n]); } }
    { float* ny = (float*)(p.ws + WS_NYQP); for (size_t i = gt; i < (size_t)NHB * 32 * 256; i += gn) { const int n = (int)(i & 255), s = (int)((i >> 8) & 31), bl = (int)(i >> 13); float a = 0.f;
          for (int tt = 0; tt < 128; ++tt) { const int t = s * 128 + tt; const float x = bf2f(paux[(size_t)(bl * TL + t) * NAUX + n]); a += (tt & 1) ? -x : x; } ny[i] = a; } }
}

__device__ void ph_prepB(const Params& p, int l) {
    const int wv = get_tid() >> 6, d = get_tid() & 63;
    bf16_t* pm = (bf16_t*)(p.ws + WS_PMAIN); const bf16_t* pre2 = (const bf16_t*)(p.ws + WS_PRE2);
    bf16_t* oR = (bf16_t*)(p.ws + WS_RW_R); bf16_t* oV = (bf16_t*)(p.ws + WS_RW_V); bf16_t* oN = (bf16_t*)(p.ws + WS_RW_NKK);
    bf16_t* oB = (bf16_t*)(p.ws + WS_RW_B); bf16_t* oKD = (bf16_t*)(p.ws + WS_RW_KD); float* oW = (float*)(p.ws + WS_RW_W); float* oGA = (float*)(p.ws + WS_GA);
    bf16_t* oG = (bf16_t*)(p.ws + WS_GRW); float* oBo = (float*)(p.ws + WS_BONUS);
    const float* cw = IN(14) + (size_t)l * 3 * 768; const float* ropec = (const float*)(p.ws + WS_ROPE); const float* ropes = ropec + 4096 * 32;
    const size_t AE = (size_t)RH * 256;
    for (int it = blockIdx.x * 8 + wv; it < RH * 4; it += gridDim.x * 8) {
        const int r = it >> 2, h = it & 3, c = h * 64 + d;
        int isctx, bl, t; rowinfo(r, isctx, bl, t); const int slen = isctx ? TC : TL; const bool hp = t > 0, hn = t < slen - 1;
        const bf16_t* pc = pm + (size_t)r * NMAIN; const bf16_t* pp = pc - NMAIN; const bf16_t* pn = pc + NMAIN;
        float rkv[3];
#pragma unroll
        for (int j = 0; j < 3; ++j) { const int col = 2048 + j * 256 + c; const int wc = j * 256 + c;
            rkv[j] = (hp ? bf2f(pp[col]) : 0.f) * cw[wc] + bf2f(pc[col]) * cw[768 + wc] + (hn ? bf2f(pn[col]) : 0.f) * cw[1536 + wc]; }
        const float rr = rkv[0], kc = rkv[1], vc = rkv[2];
        float kk = kc * IN(24)[l * 256 + c]; const float ssq = wave_sum(kk * kk); kk *= rsqrtf(ssq + EPSF);
        const float ka = IN(25)[l * 256 + c], rk = IN(26)[l * 256 + c];
        const bf16_t* q2 = pre2 + (size_t)r * N2; float bonus = 0.f; const size_t o = (size_t)r * 256 + c;
#pragma unroll
        for (int dr = 0; dr < 2; ++dr) {
            const float u = IN(16)[(l * 2 + dr) * 256 + c] + bf2f(q2[dr * 256 + c]);
            const float wraw = -softplusf_(-u) - 0.5f; const float dec = __expf(-__expf(wraw));
            const float a = sigmoidf_(IN(19)[(l * 2 + dr) * 256 + c] + bf2f(q2[512 + dr * 256 + c]));
            const float kd = kc * (1.0f + (a - 1.0f) * ka); const float bb = kk * a;
            bonus += wave_sum(rr * kd * rk) * vc;
            oW[dr * AE + o] = dec; oB[dr * AE + o] = f2bf(bb); oKD[dr * AE + o] = f2bf(kd);
            const float z = bf2f(q2[1280 + dr * 256 + c]) + IN(11)[(l * 2 + dr) * 256 + c];
            oGA[dr * AE + o] = __expf(-softplusf_(-z) * (1.0f / 16.0f));
        }
        oR[o] = f2bf(rr); oV[o] = f2bf(vc); oN[o] = f2bf(-kk); oBo[o] = bonus; oG[o] = q2[1024 + c];
        if (!isctx) {
            const float cs = ropec[t * 32 + (d & 31)], sn = ropes[t * 32 + (d & 31)];
#pragma unroll
            for (int j = 0; j < 2; ++j) { bf16_t* e = pm + (size_t)r * NMAIN + 1024 + j * 256 + c; const float x = bf2f(*e); const float y = __shfl_xor(x, 32, 64);
                const float ov = (d < 32) ? (x * cs - y * sn) : (y * sn + x * cs); *e = f2bf(ov); }
        }
    }
}

template <int MIX  >
__device__ void scan_body(const Params& p, int seq, int rhalf, unsigned char* shm) {
    const int tid = get_tid(), wv = tid >> 6, lane = tid & 63, rrow = lane >> 4, ks = lane & 15;
    const int bl = seq >> 3, h = (seq >> 1) & 3, dr = seq & 1;
    const int rowl = wv * 4 + rrow;
    const int row = rhalf * 32 + rowl;
    const size_t AE = (size_t)RH * 256;
    float* buf = (float*)shm;
    float* ybuf = (float*)(shm + 98304);
    const int sst = tid >> 4, sc4 = (tid & 15) * 4;
    const bf16_t* pm = (const bf16_t*)(p.ws + WS_PMAIN);
    float gam = 1.0f; if (MIX == 2) { const int hh = dr ? (3 - h) : h; gam = 1.0f - exp2f(-5.0f - (float)hh); }
    f32x4 st = (f32x4){0.f, 0.f, 0.f, 0.f};
    f32x4 rg[6];
    constexpr int NCH = (TC + TL) / 32;
    auto tokrow = [&](int pidx) -> int { if (pidx < TC) { const int tt = dr ? (TC - 1 - pidx) : pidx; return RLH + bl * TC + tt; } const int q = pidx - TC; const int tt = dr ? (TL - 1 - q) : q; return bl * TL + tt; };
    auto ld_bf4 = [&](const bf16_t* base, size_t off) -> f32x4 { const u32x2 w = *(const u32x2*)(base + off); f32x4 v; v[0] = __uint_as_float(w.x << 16); v[1] = __uint_as_float(w.x & 0xFFFF0000u); v[2] = __uint_as_float(w.y << 16); v[3] = __uint_as_float(w.y & 0xFFFF0000u); return v; };
    auto load_regs = [&](int ch) {
        const int r = tokrow(ch * 32 + sst); const int c = h * 64 + sc4;
        if (MIX == 0) { const size_t o = (size_t)r * 256 + c;
            rg[0] = ld_bf4((const bf16_t*)(p.ws + WS_RW_NKK), o); rg[1] = *(const f32x4*)((const float*)(p.ws + WS_RW_W) + dr * AE + o);
            rg[2] = ld_bf4((const bf16_t*)(p.ws + WS_RW_B), dr * AE + o); rg[3] = ld_bf4((const bf16_t*)(p.ws + WS_RW_KD), dr * AE + o);
            rg[4] = ld_bf4((const bf16_t*)(p.ws + WS_RW_R), o); rg[5] = ld_bf4((const bf16_t*)(p.ws + WS_RW_V), o);
        } else if (MIX == 1) { const size_t o = (size_t)r * NMAIN + c;
            rg[1] = *(const f32x4*)((const float*)(p.ws + WS_GA) + dr * AE + (size_t)r * 256 + c);
            rg[3] = ld_bf4(pm, o + 256); rg[4] = ld_bf4(pm, o); rg[5] = ld_bf4(pm, o + 512);
        } else { const size_t o = (size_t)r * NMAIN + 1024 + c;
            rg[3] = ld_bf4(pm, o + 256); rg[4] = ld_bf4(pm, o); rg[5] = ld_bf4(pm, o + 512); }
    };
    auto store_lds = [&](int b) {
        float* bb = buf + (size_t)b * 6 * 2048 + sst * 64 + sc4;
        if (MIX == 0) { *(f32x4*)(bb) = rg[0]; *(f32x4*)(bb + 2 * 2048) = rg[2]; }
        if (MIX != 2) *(f32x4*)(bb + 1 * 2048) = rg[1];
        *(f32x4*)(bb + 3 * 2048) = rg[3]; *(f32x4*)(bb + 4 * 2048) = rg[4]; *(f32x4*)(bb + 5 * 2048) = rg[5];
    };
    bf16_t* outb = (bf16_t*)(p.ws + WS_SO) + (size_t)((MIX == 0 ? 4 : (MIX == 1 ? 0 : 2)) + dr) * AE;
    load_regs(0); store_lds(0); __syncthreads();
    for (int ch = 0; ch < NCH; ++ch) {
        if (ch + 1 < NCH) load_regs(ch + 1);
        const float* bb = buf + (size_t)(ch & 1) * 6 * 2048; float* yb = ybuf + (ch & 1) * 1024;
#pragma unroll 2
        for (int s = 0; s < 32; ++s) {
            const float* bs = bb + s * 64 + ks * 4;
            const f32x4 kd = *(const f32x4*)(bs + 3 * 2048), rv = *(const f32x4*)(bs + 4 * 2048); const float vv = bb[5 * 2048 + s * 64 + row];
            if (MIX == 0) {
                const f32x4 a = *(const f32x4*)(bs), w = *(const f32x4*)(bs + 1 * 2048), b = *(const f32x4*)(bs + 2 * 2048);
                float sa = st[0] * a[0] + st[1] * a[1] + st[2] * a[2] + st[3] * a[3]; sa = row16_allsum(sa);
#pragma unroll
                for (int j = 0; j < 4; ++j) st[j] = st[j] * w[j] + (sa * b[j] + vv * kd[j]);
            } else if (MIX == 1) {
                const f32x4 w = *(const f32x4*)(bs + 1 * 2048);
#pragma unroll
                for (int j = 0; j < 4; ++j) st[j] = st[j] * w[j] + vv * kd[j];
            } else {
#pragma unroll
                for (int j = 0; j < 4; ++j) st[j] = st[j] * gam + vv * kd[j];
            }
            float y = st[0] * rv[0] + st[1] * rv[1] + st[2] * rv[2] + st[3] * rv[3]; y = row16_allsum(y);
            if (ks == 0) yb[s * 32 + rowl] = y;
        }
        if (ch + 1 < NCH) store_lds((ch + 1) & 1);
        __syncthreads();
        { const int s = tid >> 4, r2 = (tid & 15) * 2; const int r = tokrow(ch * 32 + s);
          const unsigned w = cvt_pk_bf16(yb[s * 32 + r2], yb[s * 32 + r2 + 1]);
          *(unsigned*)(outb + (size_t)r * 256 + h * 64 + rhalf * 32 + r2) = w; }
    }
}

__device__ void ph_branch(const Params& p, int l, int nrows, float* shf) {
    const int tid = get_tid(), wv = tid >> 6, d = tid & 63;
    if (tid < 256) { float s, c2; sincospif((float)tid * (1.0f / 128.0f), &s, &c2); shf[tid] = c2; shf[256 + tid] = s; }
    __syncthreads();
    const bf16_t* pm = (const bf16_t*)(p.ws + WS_PMAIN); const bf16_t* so = (const bf16_t*)(p.ws + WS_SO); const size_t AE = (size_t)RH * 256;
    const bf16_t* grw = (const bf16_t*)(p.ws + WS_GRW); const float* bon = (const float*)(p.ws + WS_BONUS);
    const float* fc = (const float*)(p.ws + WS_FC); const float* fs = (const float*)(p.ws + WS_FS); const float* g2048 = (const float*)(p.ws + WS_GR2048);
    const float* nyq = (const float*)(p.ws + WS_NYQP); const bf16_t* gc = (const bf16_t*)(p.ws + WS_GC);
    bf16_t* outs = (bf16_t*)(p.ws + WS_OUTS);
    for (int it = blockIdx.x * 8 + wv; it < nrows * 4; it += gridDim.x * 8) {
        const int r = it >> 2, h = it & 3, c = h * 64 + d; const size_t o = (size_t)r * 256 + c;
        int isctx, bl, t; rowinfo(r, isctx, bl, t);
        const bf16_t* pc = pm + (size_t)r * NMAIN;
        float og = bf2f(so[0 * AE + o]) + bf2f(so[1 * AE + o]);
        { const float ms = wave_sum(og * og) * (1.0f / 64.0f); og = og * rsqrtf(ms + EPSF) * IN(12)[l * 256 + c] * siluf_(bf2f(pc[768 + c])); }
        float orr = bf2f(so[2 * AE + o]) + bf2f(so[3 * AE + o]);
        { const float mean = wave_sum(orr) * (1.0f / 64.0f); orr -= mean; const float var = wave_sum(orr * orr) * (1.0f / 64.0f); orr = orr * rsqrtf(var + EPSF) * IN(13)[l * 256 + c] * siluf_(bf2f(pc[1792 + c])); }
        float ow = bf2f(so[4 * AE + o]) + bf2f(so[5 * AE + o]);
        { const float mean = wave_sum(ow) * (1.0f / 64.0f); ow -= mean; const float var = wave_sum(ow * ow) * (1.0f / 64.0f); ow = (ow * rsqrtf(var + EPSF) * IN(27)[l * 256 + c] + bon[o]) * bf2f(grw[o]); }
        float of;
        if (!isctx) {
            const float sg = (t & 1) ? -1.0f : 1.0f; const int col = bl * 256 + c;
            if (t < 2048) of = fc[(size_t)t * 1024 + col] + fs[(size_t)t * 1024 + col] + sg * g2048[col];
            else if (t == 2048) { float a = 0.f; for (int s = 0; s < 32; ++s) a += nyq[((size_t)bl * 32 + s) * 256 + c]; of = a; }
            else { const int t2 = 4096 - t; of = fc[(size_t)t2 * 1024 + col] - fs[(size_t)t2 * 1024 + col] + sg * g2048[col]; }
            of *= (1.0f / 512.0f);
        } else {
            float a = 0.f; const bf16_t* gb = gc + (size_t)bl * 256 * 512 + c;
            for (int tt = 0; tt < 256; ++tt) { const int m = (tt * t) & 255; a += shf[m] * bf2f(gb[(size_t)tt * 512]) + shf[256 + m] * bf2f(gb[(size_t)tt * 512 + 256]); }
            of = a * (1.0f / 128.0f);
        }
        bf16_t* orow = outs + (size_t)r * 1024 + c;
        orow[0] = f2bf(og); orow[256] = f2bf(orr); orow[512] = f2bf(ow); orow[768] = f2bf(of);
    }
}

__device__ void ph_act(const Params& p, int l, int nrows) {
    const size_t gt = (size_t)blockIdx.x * 512 + get_tid(), gn = (size_t)gridDim.x * 512;
    const bf16_t* U = (const bf16_t*)(p.ws + WS_U); bf16_t* A = (bf16_t*)(p.ws + WS_ACT);
    const float* cw = IN(33) + (size_t)l * 3 * DFF; const float* cb = IN(34) + (size_t)l * DFF;
    const size_t items = (size_t)nrows * 352;
    for (size_t it = gt; it < items; it += gn) {
        const int r = (int)(it / 352), j0 = (int)(it % 352) * 8;
        int isctx, bl, t; rowinfo(r, isctx, bl, t); const int slen = isctx ? TC : TL; const bool hp = t > 0, hn = t < slen - 1;
        const bf16_t* uc = U + (size_t)r * 5632 + j0;
        const u32x4 z4 = (u32x4){0u, 0u, 0u, 0u};
        const u32x4 ac = *(const u32x4*)uc, ap = hp ? *(const u32x4*)(uc - 5632) : z4, an = hn ? *(const u32x4*)(uc + 5632) : z4, uu = *(const u32x4*)(uc + 2816);
        float o[8];
#pragma unroll
        for (int j = 0; j < 8; ++j) { const unsigned wcur = ac[j >> 1], wp = ap[j >> 1], wn = an[j >> 1], wu = uu[j >> 1];
            const float xc = (j & 1) ? __uint_as_float(wcur & 0xFFFF0000u) : __uint_as_float(wcur << 16), xp = (j & 1) ? __uint_as_float(wp & 0xFFFF0000u) : __uint_as_float(wp << 16),
                        xn = (j & 1) ? __uint_as_float(wn & 0xFFFF0000u) : __uint_as_float(wn << 16), xu = (j & 1) ? __uint_as_float(wu & 0xFFFF0000u) : __uint_as_float(wu << 16);
            const float a = xp * cw[j0 + j] + xc * cw[DFF + j0 + j] + xn * cw[2 * DFF + j0 + j] + cb[j0 + j];
            o[j] = siluf_(a) * xu; }
        u32x4 w; w.x = cvt_pk_bf16(o[0], o[1]); w.y = cvt_pk_bf16(o[2], o[3]); w.z = cvt_pk_bf16(o[4], o[5]); w.w = cvt_pk_bf16(o[6], o[7]);
        *(u32x4*)(A + (size_t)r * DFF + j0) = w;
    }
}

#ifndef SUBMASK
#define SUBMASK 0x3FFF
#define ALLSTEPS 1
#endif
#define ON(s) (((SUBMASK) >> (s)) & 1)
constexpr int STEPS_PER_PASS = 14, NSTEPS = 2 + 4 * STEPS_PER_PASS + 1;

__device__ __forceinline__ void run_step(const Params& p, int step, unsigned char* shm) {
    float* shf = (float*)shm; LAS unsigned char* lds = (LAS unsigned char*)shm;
    const int G = gridDim.x, c = blockIdx.x;
#ifdef ALLSTEPS
    if (step == 0) { ph_setup(p, shf); return; }
    if (step == 1) { ph_modreduce(p); ph_wconv(p, 0, shf); return; }
    if (step == NSTEPS - 1) { ph_final(p); return; }
#endif
    const int ps = step - 2, pass = ps / STEPS_PER_PASS, sub = ps % STEPS_PER_PASS, l = pass >> 1, half = pass & 1;
    const bool need_ctx = (l == 0); const int Mpost = need_ctx ? RH : RLH;
    const float* modl = (const float*)(p.ws + WS_MOD) + (size_t)l * 9 * 6144;
    Sched S; Prob P; EpiU E{}; bool do_gemm = false;
    E.xlat = p.out; E.xctx = (float*)(p.ws + WS_XCTX); E.half = half; E.modl = modl;
    switch (sub) {
    case 0: if (ON(0)) { if (l == 1 && half == 0) ph_wconv(p, 1, shf); ph_norm(p, l, half, 0, RH); } break;
    case 1: if (ON(1)) { S.init(RH, N1, 1, G, c); P = Prob{(const bf16_t*)(p.ws + WS_HB), (const bf16_t*)(p.ws + WS_W1T), 1024, 1024, 16, 0, 0};
        E.mode = 0; E.O = p.ws + WS_PMAIN; E.O2 = p.ws + WS_PAUX; do_gemm = true; } break;
    case 2: if (ON(2)) ph_prepA(p, shf); break;
    case 3: if (ON(3)) { S.init(RH, N2, 1, G, c); P = Prob{(const bf16_t*)(p.ws + WS_A2), (const bf16_t*)(p.ws + WS_W2T), K2, K2, K2 / 64, 0, 0};
        E.mode = 1; E.O = p.ws + WS_PRE2; E.ldc = N2; do_gemm = true; } break;
    case 4: if (ON(4)) ph_prepB(p, l); break;
    case 5: if (ON(5)) { if (c < NWG_SCAN) { const int seq = c / 6, rem = c % 6, mix = rem >> 1, rhalf = rem & 1;
            if (mix == 0) scan_body<0>(p, seq, rhalf, shm); else if (mix == 1) scan_body<1>(p, seq, rhalf, shm); else scan_body<2>(p, seq, rhalf, shm);
        } else {
            S.init(2048, 1024, 2, G - NWG_SCAN, c - NWG_SCAN);
            P = Prob{(const bf16_t*)(p.ws + WS_CMAT), (const bf16_t*)(p.ws + WS_ERT), 2048, 2048, 32, (size_t)2048 * 2048, (size_t)1024 * 2048};
            E.mode = 5; E.O = p.ws + WS_FC; E.ldc = 1024; E.seg_stride = (size_t)2048 * 1024; do_gemm = true; } }
        break;
    case 6: if (ON(6)) ph_branch(p, l, Mpost, shf); break;
    case 7: if (ON(7)) { S.init(Mpost, 4096, 1, G, c); P = Prob{(const bf16_t*)(p.ws + WS_HB), (const bf16_t*)(p.ws + WS_WGT), 1024, 1024, 16, 0, 0};
        E.mode = 2; E.O = p.ws + WS_GBUF; E.ldc = 4096; E.bias = IN(29) + (size_t)l * 4096; do_gemm = true; } break;
    case 8: if (ON(8)) { S.init(Mpost, 1024, 4, G, c); P = Prob{(const bf16_t*)(p.ws + WS_OUTS), (const bf16_t*)(p.ws + WS_WBRT), 1024, 256, 4, 256, (size_t)1024 * 256};
        E.mode = 3; E.O = p.ws + WS_Z; E.O2 = p.ws + WS_GBUF; do_gemm = true; } break;
    case 9: if (ON(9)) { S.init(Mpost, 1024, 1, G, c); P = Prob{(const bf16_t*)(p.ws + WS_Z), (const bf16_t*)(p.ws + WS_WOUTT), 1024, 1024, 16, 0, 0};
        E.mode = 4; E.gidx = 2; do_gemm = true; } break;
    case 10: if (ON(10)) ph_norm(p, l, half, 1, Mpost); break;
    case 11: if (ON(11)) { S.init(Mpost, 5632, 1, G, c); P = Prob{(const bf16_t*)(p.ws + WS_HB), (const bf16_t*)(p.ws + WS_WUPT), 1024, 1024, 16, 0, 0};
        E.mode = 1; E.O = p.ws + WS_U; E.ldc = 5632; do_gemm = true; } break;
    case 12: if (ON(12)) ph_act(p, l, Mpost); break;
    case 13: if (ON(13)) { S.init(Mpost, 1024, 1, G, c); P = Prob{(const bf16_t*)(p.ws + WS_ACT), (const bf16_t*)(p.ws + WS_WDNT), DFF, DFF, DFF / 64, 0, 0};
        E.mode = 4; E.gidx = 5; do_gemm = true; } break;
    }
    if (do_gemm) gemm_phase(lds, P, S, E);
}

__global__ void __launch_bounds__(512, 2) fwd_megakernel(KArgs ka) {
    unsigned char* shm = g_shm;
    cg::grid_group grid = cg::this_grid();
    if (threadIdx.x == 0) {
#pragma unroll
        for (int i = 0; i < 37; ++i) ((const float**)(g_shm + 131072))[i] = ka.in[i];
    }
    __syncthreads();
    for (int step = ka.step_lo; step < ka.step_hi; ++step) {
        Params p; p.out = ka.out; p.ws = ka.ws;
        asm volatile("" : "+s"(p.out), "+s"(p.ws));
        run_step(p, step, shm);
        if (step + 1 < ka.step_hi) { __syncthreads(); grid.sync(); }
    }
}

extern "C" void kernel_launch(void* const* d_in, const int* in_sizes, int n_in, void* d_out, int out_size, void* d_ws, size_t ws_size, hipStream_t stream) {
    static int grid = 0;
    if (grid == 0) {
        if (n_in != 37 || ws_size < WS_END) { fprintf(stderr, "kernel_launch: need 37 inputs and >= %zu bytes of workspace; got n_in %d, ws %zu\n", (size_t)WS_END, n_in, ws_size); grid = -1; return; }
        if (hipFuncSetAttribute((const void*)fwd_megakernel, hipFuncAttributeMaxDynamicSharedMemorySize, LDS_BYTES) != hipSuccess) { fprintf(stderr, "kernel_launch: hipFuncSetAttribute failed\n"); grid = -1; return; }
        int dev = 0, cus = 0, per_cu = 0; (void)hipGetDevice(&dev); (void)hipDeviceGetAttribute(&cus, hipDeviceAttributeMultiprocessorCount, dev);
        (void)hipOccupancyMaxActiveBlocksPerMultiprocessor(&per_cu, (const void*)fwd_megakernel, 512, LDS_BYTES);
        if (per_cu < 1 || cus != 256) fprintf(stderr, "kernel_launch: note: cus %d per_cu %d\n", cus, per_cu);
        (void)hipGetLastError();
        grid = 256;
    }
    if (grid < 0) return;
    KArgs p{};
    for (int i = 0; i < 37; ++i) p.in[i] = (const float*)d_in[i];
    p.out = (float*)d_out; p.ws = (unsigned char*)d_ws;
#if USE_COOP
    p.step_lo = 0; p.step_hi = NSTEPS;
    void* args[] = {&p};
    hipError_t e = hipLaunchCooperativeKernel((const void*)fwd_megakernel, dim3(grid), dim3(512), args, LDS_BYTES, stream);
    if (e != hipSuccess) fprintf(stderr, "cooperative launch failed: %s\n", hipGetErrorString(e));
#else
    for (int s = 0; s < NSTEPS; ++s) { p.step_lo = s; p.step_hi = s + 1; hipLaunchKernelGGL(fwd_megakernel, dim3(grid), dim3(512), LDS_BYTES, stream, p); }
#endif
}
```

```cpp
#include <hip/hip_runtime.h>
#include <hip/hip_cooperative_groups.h>
#include <cstdio>
namespace cg = cooperative_groups;

#ifndef USE_COOP
#define USE_COOP 1
#endif

#define LAS __attribute__((address_space(3)))
typedef unsigned short bf16_t;
typedef short bf16x8 __attribute__((ext_vector_type(8)));
typedef float f32x4 __attribute__((ext_vector_type(4)));
typedef unsigned u32x4 __attribute__((ext_vector_type(4)));
typedef unsigned u32x2 __attribute__((ext_vector_type(2)));

constexpr int DM = 1024, NBATCH = 8, TL = 4096, TC = 256, NLAYER = 2;
constexpr int NHB = 4;
constexpr int RLH = NHB * TL;
constexpr int RCH = NHB * TC;
constexpr int RH = RLH + RCH;
constexpr int N1 = 4352, NMAIN = 2816, NAUX = 1536, K2 = 512, N2 = 1792, DFF = 2816;
constexpr float EPSF = 1e-6f;
constexpr int NWG_SCAN = 192;

constexpr size_t al256(size_t x) { return (x + 255) & ~(size_t)255; }
constexpr size_t WS_W1T = 0;
constexpr size_t WS_WGT = WS_W1T + (size_t)N1 * 1024 * 2;
constexpr size_t WS_W2T = WS_WGT + (size_t)4096 * 1024 * 2;
constexpr size_t WS_WBRT = WS_W2T + (size_t)N2 * K2 * 2;
constexpr size_t WS_WOUTT = WS_WBRT + (size_t)4 * 1024 * 256 * 2;
constexpr size_t WS_WUPT = WS_WOUTT + (size_t)1024 * 1024 * 2;
constexpr size_t WS_WDNT = WS_WUPT + (size_t)5632 * 1024 * 2;
constexpr size_t WS_CMAT = WS_WDNT + (size_t)1024 * 2816 * 2;
constexpr size_t WS_SMAT = WS_CMAT + (size_t)2048 * 2048 * 2;
constexpr size_t WS_MODP = WS_SMAT + (size_t)2048 * 2048 * 2;
constexpr size_t WS_MOD = WS_MODP + (size_t)16 * 2 * 9 * 6144 * 4;
constexpr size_t WS_ROPE = WS_MOD + (size_t)2 * 9 * 6144 * 4;
constexpr size_t WS_XCTX = WS_ROPE + (size_t)4096 * 32 * 2 * 4;
constexpr size_t WS_GR2048 = WS_XCTX + (size_t)2048 * 1024 * 4;
constexpr size_t WS_GC = WS_GR2048 + (size_t)4 * 256 * 4;
constexpr size_t WS_NYQP = WS_GC + (size_t)4 * 256 * 512 * 2;
constexpr size_t WS_ERT = WS_NYQP + (size_t)4 * 32 * 256 * 4;
constexpr size_t WS_OIT = WS_ERT + (size_t)1024 * 2048 * 2;
constexpr size_t WS_FC = WS_OIT + (size_t)1024 * 2048 * 2;
constexpr size_t WS_FS = WS_FC + (size_t)2048 * 1024 * 4;
constexpr size_t WS_BAR = WS_FS + (size_t)2048 * 1024 * 4;
constexpr size_t WS_HB = WS_BAR + 16384;
constexpr size_t WS_BIG = WS_HB + (size_t)RH * 1024 * 2;
constexpr size_t ARR2 = (size_t)RH * 256 * 2, ARR4 = (size_t)RH * 256 * 4;
constexpr size_t WS_PMAIN = WS_BIG;
constexpr size_t WS_PRE2 = WS_PMAIN + (size_t)RH * NMAIN * 2;
constexpr size_t WS_SCIN = WS_PRE2 + (size_t)RH * N2 * 2;
constexpr size_t WS_PAUX = WS_SCIN;
constexpr size_t WS_A2 = WS_PAUX + (size_t)RH * NAUX * 2;
constexpr size_t WS_RW_R = WS_SCIN, WS_RW_V = WS_RW_R + ARR2, WS_RW_NKK = WS_RW_V + ARR2, WS_RW_B = WS_RW_NKK + ARR2  ,
                 WS_RW_KD = WS_RW_B + 2 * ARR2  , WS_RW_W = WS_RW_KD + 2 * ARR2  , WS_GA = WS_RW_W + 2 * ARR4  ,
                 WS_GRW = WS_GA + 2 * ARR4, WS_BONUS = WS_GRW + ARR2, WS_SCIN_END = WS_BONUS + ARR4;
constexpr size_t WS_SO = WS_PRE2;
constexpr size_t WS_OUTS = WS_SCIN;
constexpr size_t WS_Z = WS_OUTS + (size_t)RH * 1024 * 2;
constexpr size_t WS_GBUF = WS_PMAIN;
constexpr size_t WS_U = WS_PMAIN;
constexpr size_t WS_ACT = WS_U + (size_t)RH * 5632 * 2;
constexpr size_t WS_END = (WS_SCIN_END > WS_ACT + (size_t)RH * 2816 * 2) ? WS_SCIN_END : WS_ACT + (size_t)RH * 2816 * 2;
static_assert(6 * ARR2 <= (size_t)RH * N2 * 2, "scan outs fit PRE2");
static_assert(WS_Z + (size_t)RH * 1024 * 2 <= WS_GRW, "outs+z inside dead scan inputs");
static_assert(WS_GBUF + (size_t)RH * 4096 * 2 <= WS_SCIN, "gbuf fits");
static_assert(WS_A2 + (size_t)RH * K2 * 2 <= WS_SCIN_END, "a2 fits");

constexpr int LDS_BYTES = 131072 + 8192;

struct KArgs {
    const float* in[37];
    float* out;
    unsigned char* ws;
    int step_lo, step_hi;
};
struct Params { float* out; unsigned char* ws; };

extern __shared__ __attribute__((aligned(16))) unsigned char g_shm[];
#define IN(k) (((const float* const*)(g_shm + 131072))[k])

__device__ __forceinline__ int get_tid() { int t = threadIdx.x; asm volatile("" : "+v"(t)); return t; }
__device__ __forceinline__ float bf2f(bf16_t b) { return __uint_as_float(((unsigned)b) << 16); }
__device__ __forceinline__ bf16_t f2bf(float f) { unsigned u = __float_as_uint(f); u += 0x7FFFu + ((u >> 16) & 1u); return (bf16_t)(u >> 16); }
__device__ __forceinline__ unsigned cvt_pk_bf16(float lo, float hi) { unsigned r; asm volatile("v_cvt_pk_bf16_f32 %0, %1, %2" : "=v"(r) : "v"(lo), "v"(hi)); return r; }
__device__ __forceinline__ float sigmoidf_(float x) { return __builtin_amdgcn_rcpf(1.0f + __expf(-x)); }
__device__ __forceinline__ float siluf_(float x) { return x * sigmoidf_(x); }
__device__ __forceinline__ float softplusf_(float x) { return fmaxf(x, 0.f) + log1pf(__expf(-fabsf(x))); }
__device__ __forceinline__ float wave_sum(float v) {
#pragma unroll
    for (int o = 32; o > 0; o >>= 1) v += __shfl_xor(v, o, 64);
    return v;
}
template <int CTRL> __device__ __forceinline__ float dpp_f(float x) { return __int_as_float(__builtin_amdgcn_update_dpp(0, __float_as_int(x), CTRL, 0xF, 0xF, false)); }
__device__ __forceinline__ float row16_allsum(float x) {
    x += dpp_f<0x128>(x); x += dpp_f<0x124>(x); x += dpp_f<0x122>(x); x += dpp_f<0x121>(x); return x;
}
__device__ __forceinline__ void rowinfo(int r, int& isctx, int& bl, int& t) {
    if (r < RLH) { isctx = 0; bl = r >> 12; t = r & 4095; } else { const int rc = r - RLH; isctx = 1; bl = rc >> 8; t = rc & 255; }
}
__device__ __forceinline__ float* xrow_ptr(const Params& p, int half, int r) {
    int isctx, bl, t; rowinfo(r, isctx, bl, t); const int b = half * NHB + bl;
    return isctx ? ((float*)(p.ws + WS_XCTX) + ((size_t)b * TC + t) * DM) : (p.out + ((size_t)b * TL + t) * DM);
}

constexpr int BM = 256, BN = 128, BK = 64, HTB = 128 * BK * 2, STG = 3 * HTB, NXCD = 8, WGM = 8;
__device__ __forceinline__ int lds_byte(int r, int c) { const int st = (r >> 4) * 2 + (c >> 5), rr = r & 15, cc = c & 31, ob = rr * 64 + cc * 2; return st * 1024 + (ob ^ (((ob >> 9) & 1) << 5)); }
__device__ __forceinline__ void stage_rc(int b, int& R, int& C) { const int st = b / 1024, sb = b % 1024, swz = sb ^ (((sb >> 9) & 1) << 5); R = (st >> 1) * 16 + swz / 64; C = (st & 1) * 32 + (swz % 64) / 2; }
__device__ __forceinline__ int perm32(int rho) { const int n = rho >> 4, i = rho & 15; return 8 * (i >> 2) + 4 * n + (i & 3); }

struct Unit { int pm, pn, seg; };
struct Sched {
    int nM, nN, nseg, ntiles, G, c;
    __device__ void init(int M, int N, int nseg_, int G_, int c_) { nM = M / BM; nN = N / BN; nseg = nseg_; ntiles = nM * nN; G = G_; c = c_; }
    __device__ bool next(int i, Unit& u) const {
        const int ti = i / nseg; const long L = (long)ti * G + c; if (L >= ntiles) return false;
        u.seg = i - ti * nseg;
        int wgid = (int)L; { const int q = ntiles / NXCD, r = ntiles % NXCD, xcd = wgid % NXCD, off = wgid / NXCD; wgid = (xcd < r ? xcd * (q + 1) : r * (q + 1) + (xcd - r) * q) + off; }
        const int nig = WGM * nN, gid = wgid / nig, fm = gid * WGM, gsz = (nM - fm) < WGM ? (nM - fm) : WGM;
        u.pm = fm + ((wgid % nig) % gsz); u.pn = (wgid % nig) / gsz; return true;
    }
};
struct Prob {
    const bf16_t* A; const bf16_t* Bt; int lda, ldb, nt; size_t a_seg, b_seg;
    __device__ __forceinline__ void ptrs(const Unit& u, const char*& a, const char*& b) const {
        a = (const char*)(A + (size_t)u.pm * BM * lda + (size_t)u.seg * a_seg);
        b = (const char*)(Bt + (size_t)u.pn * BN * ldb + (size_t)u.seg * b_seg);
    }
};

typedef f32x4 Acc[4][4];
__device__ __forceinline__ void acc_zero(Acc& acc) {
#pragma unroll
    for (int m = 0; m < 4; ++m)
#pragma unroll
        for (int n = 0; n < 4; ++n) acc[m][n] = (f32x4){0.f, 0.f, 0.f, 0.f};
}
struct EpiU;
__device__ __forceinline__ void epi_apply(const EpiU& E, int mode, const Acc& acc, const Unit& u, int wr, int wc, int fr, int fq);
__device__ __forceinline__ void epi_rescale(const EpiU& E, Acc& acc, const Unit& u, int wr, int wc, int fr, int fq);
__device__ __forceinline__ int epi_mode(const EpiU& E);

__device__ __forceinline__ void gemm_phase(LAS unsigned char* lds, const Prob P, const Sched& S, const EpiU& E) {
    const int tid = get_tid(), wid = __builtin_amdgcn_readfirstlane(tid >> 6), lane = tid & 63, wr = wid >> 1, wc = wid & 1, fr = lane & 15, fq = lane >> 4;
    const int nt = P.nt; const int mode = epi_mode(E); const bool perm = mode < 4;
    unsigned voffA[2], voffB[2];
#pragma unroll
    for (int i = 0; i < 2; ++i) { int R, C; stage_rc(tid * 16 + i * 8192, R, C); const int Rb = perm ? ((R & ~31) + perm32(R & 31)) : R;
        voffA[i] = (unsigned)(R * P.lda + C) * 2u; voffB[i] = (unsigned)(Rb * P.ldb + C) * 2u; }
    const size_t kstep = (size_t)(BK * 2), hstepA = (size_t)128 * P.lda * 2;
    const unsigned ldsw = (unsigned)wid * 1024u;
    const int aoff = (wr >> 1) * HTB + lds_byte((wr & 1) * 64 + fr, fq * 8), boff = 2 * HTB + lds_byte(wc * 64 + fr, fq * 8);
#define G_STAGE1(bufoff, gbase, voff) do { _Pragma("unroll") for (int _i = 0; _i < 2; ++_i) \
        __builtin_amdgcn_global_load_lds((const unsigned*)((const char*)(gbase) + (voff)[_i]), (LAS unsigned*)(lds + (bufoff) + ldsw + _i * 8192), 16, 0, 0); } while (0)
#define G_STAGE(s, ga, gb) do { G_STAGE1((s) * STG, ga, voffA); G_STAGE1((s) * STG + HTB, (ga) + hstepA, voffA); G_STAGE1((s) * STG + 2 * HTB, gb, voffB); } while (0)
#define G_WAIT_V(n) asm volatile("s_waitcnt vmcnt(" #n ")" ::: "memory")
#define G_BAR do { asm volatile("" ::: "memory"); __builtin_amdgcn_s_barrier(); asm volatile("" ::: "memory"); } while (0)
    Unit cur, nxt; int ui = 0;
    if (!S.next(0, cur)) return;
    Acc acc; acc_zero(acc);
    const char* cA; const char* cB; P.ptrs(cur, cA, cB);
    G_STAGE(0, cA, cB);
    for (;;) {
        const bool has_next = S.next(ui + 1, nxt);
        const char* nA = cA; const char* nB = cB; if (has_next) P.ptrs(nxt, nA, nB);
        for (int t = 0; t < nt; ++t) {
            const int s = t & 1;
            if (t + 1 < nt) { G_STAGE(s ^ 1, cA + (size_t)(t + 1) * kstep, cB + (size_t)(t + 1) * kstep); G_WAIT_V(6); }
            else if (has_next) { G_STAGE(s ^ 1, nA, nB); G_WAIT_V(6); }
            else { G_WAIT_V(0); }
            G_BAR;
            bf16x8 Af[4][2], Bf[4][2];
#pragma unroll
            for (int m = 0; m < 4; ++m)
#pragma unroll
                for (int k = 0; k < 2; ++k) Af[m][k] = *(const LAS bf16x8*)(lds + s * STG + aoff + m * 2048 + k * 1024);
#pragma unroll
            for (int n = 0; n < 4; ++n)
#pragma unroll
                for (int k = 0; k < 2; ++k) Bf[n][k] = *(const LAS bf16x8*)(lds + s * STG + boff + n * 2048 + k * 1024);
#pragma unroll
            for (int k = 0; k < 2; ++k)
#pragma unroll
                for (int m = 0; m < 4; ++m)
#pragma unroll
                    for (int n = 0; n < 4; ++n) acc[m][n] = __builtin_amdgcn_mfma_f32_16x16x32_bf16(Bf[n][k], Af[m][k], acc[m][n], 0, 0, 0);
            asm volatile("s_waitcnt lgkmcnt(0)" ::: "memory");
            G_BAR;
        }
        epi_apply(E, mode, acc, cur, wr, wc, fr, fq);
        if (mode == 3 && cur.seg < 3) epi_rescale(E, acc, cur, wr, wc, fr, fq); else acc_zero(acc);
        if (!has_next) break;
        cur = nxt; cA = nA; cB = nB; ++ui;
    }
    G_BAR;
#undef G_STAGE1
#undef G_STAGE
#undef G_WAIT_V
#undef G_BAR
}

__device__ __forceinline__ void unpack8(const u32x4 gc, float* g) {
    g[0] = __uint_as_float(gc.x << 16); g[1] = __uint_as_float(gc.x & 0xFFFF0000u); g[2] = __uint_as_float(gc.y << 16); g[3] = __uint_as_float(gc.y & 0xFFFF0000u);
    g[4] = __uint_as_float(gc.z << 16); g[5] = __uint_as_float(gc.z & 0xFFFF0000u); g[6] = __uint_as_float(gc.w << 16); g[7] = __uint_as_float(gc.w & 0xFFFF0000u);
}
struct EpiU {
    int mode;
    void* O; void* O2; int ldc; const float* bias; float* xlat; float* xctx; int half; const float* modl; int gidx; size_t seg_stride;
};
__device__ __forceinline__ int epi_mode(const EpiU& E) { return E.mode; }
__device__ __forceinline__ void epi_rescale(const EpiU& E, Acc& acc, const Unit& u, int wr, int wc, int fr, int fq) {
    const bf16_t* G = (const bf16_t*)E.O2; const int row0 = u.pm * BM + wr * 64 + fr, col0 = u.pn * BN + wc * 64 + 8 * fq, seg = u.seg;
#pragma unroll
    for (int m = 0; m < 4; ++m) { const size_t r = (size_t)(row0 + m * 16);
#pragma unroll
        for (int g2 = 0; g2 < 2; ++g2) { float g[8], h[8]; unpack8(*(const u32x4*)(G + r * 4096 + seg * 1024 + col0 + g2 * 32), g); unpack8(*(const u32x4*)(G + r * 4096 + (seg + 1) * 1024 + col0 + g2 * 32), h);
#pragma unroll
            for (int j = 0; j < 4; ++j) { acc[m][2 * g2][j] *= g[j] * __builtin_amdgcn_rcpf(h[j]); acc[m][2 * g2 + 1][j] *= g[4 + j] * __builtin_amdgcn_rcpf(h[4 + j]); } } }
}
__device__ __forceinline__ void epi_apply(const EpiU& E, int mode, const Acc& acc, const Unit& u, int wr, int wc, int fr, int fq) {
    const int row0 = u.pm * BM + wr * 64 + fr;
    if (mode < 4) {
        if (mode == 3 && u.seg != 3) return;
        bf16_t* base = (bf16_t*)E.O; int ld = E.ldc, colt = u.pn * BN;
        if (mode == 0) { if (u.pn < 22) { ld = NMAIN; } else { base = (bf16_t*)E.O2; ld = NAUX; colt = (u.pn - 22) * BN; } }
        if (mode == 3) ld = 1024;
        const int col0 = colt + wc * 64 + 8 * fq, gcol0 = u.pn * BN + wc * 64 + 8 * fq;
#pragma unroll
        for (int m = 0; m < 4; ++m) { const size_t r = (size_t)(row0 + m * 16);
#pragma unroll
            for (int g2 = 0; g2 < 2; ++g2) { f32x4 v0 = acc[m][2 * g2], v1 = acc[m][2 * g2 + 1];
                if (mode == 2) { const f32x4 b0 = *(const f32x4*)(E.bias + gcol0 + g2 * 32), b1 = *(const f32x4*)(E.bias + gcol0 + g2 * 32 + 4);
#pragma unroll
                    for (int j = 0; j < 4; ++j) { v0[j] = fmaxf(sigmoidf_(v0[j] + b0[j]), 1e-30f); v1[j] = fmaxf(sigmoidf_(v1[j] + b1[j]), 1e-30f); } }
                if (mode == 3) { float g[8]; unpack8(*(const u32x4*)((const bf16_t*)E.O2 + r * 4096 + 3 * 1024 + gcol0 + g2 * 32), g);
#pragma unroll
                    for (int j = 0; j < 4; ++j) { v0[j] *= g[j]; v1[j] *= g[4 + j]; } }
                u32x4 w; w.x = cvt_pk_bf16(v0[0], v0[1]); w.y = cvt_pk_bf16(v0[2], v0[3]); w.z = cvt_pk_bf16(v1[0], v1[1]); w.w = cvt_pk_bf16(v1[2], v1[3]);
                *(u32x4*)(base + r * ld + col0 + g2 * 32) = w; } }
    } else if (mode == 4) {
        const int pm = u.pm; int bl, isctx; if (pm < 64) { isctx = 0; bl = pm >> 4; } else { isctx = 1; bl = pm - 64; }
        const int b = E.half * NHB + bl; const int mb = isctx ? 8 : b;
        const float* mv = E.modl + (size_t)mb * 6144 + E.gidx * 1024;
        float* xb = isctx ? (E.xctx + (size_t)b * TC * DM) : (E.xlat + ((size_t)b * TL + (size_t)(pm & 15) * BM) * DM);
        const int lrow0 = wr * 64 + fr, col0 = u.pn * BN + wc * 64 + 4 * fq;
#pragma unroll
        for (int n = 0; n < 4; ++n) { const f32x4 mm = *(const f32x4*)(mv + col0 + n * 16);
#pragma unroll
            for (int m = 0; m < 4; ++m) { f32x4* q = (f32x4*)(xb + (size_t)(lrow0 + m * 16) * DM + col0 + n * 16); *q = *q + mm * acc[m][n]; } }
    } else {
        float* base = (float*)E.O + (size_t)u.seg * E.seg_stride; const int col0 = u.pn * BN + wc * 64 + 4 * fq;
#pragma unroll
        for (int m = 0; m < 4; ++m)
#pragma unroll
            for (int n = 0; n < 4; ++n) *(f32x4*)(base + (size_t)(row0 + m * 16) * E.ldc + col0 + n * 16) = acc[m][n];
    }
}

__device__ void ph_setup(const Params& p, float* shf) {
    const size_t gt = (size_t)blockIdx.x * 512 + get_tid(), gn = (size_t)gridDim.x * 512;
    { const f32x4* s = (const f32x4*)IN(0); f32x4* d = (f32x4*)p.out; const size_t n = (size_t)NBATCH * TL * DM / 4; for (size_t i = gt; i < n; i += gn) d[i] = s[i]; }
    { const f32x4* s = (const f32x4*)IN(2); f32x4* d = (f32x4*)(p.ws + WS_XCTX); const size_t n = (size_t)NBATCH * TC * DM / 4; for (size_t i = gt; i < n; i += gn) d[i] = s[i]; }
    { float* modp = (float*)(p.ws + WS_MODP); const float* c = IN(1); const float* cc = IN(3); const float* wa = IN(4);
      const size_t items = (size_t)16 * 2 * 6144;
      for (size_t it = gt; it < items; it += gn) { const int n = (int)(it % 6144); const int l = (int)((it / 6144) & 1); const int kc = (int)(it / (6144 * 2));
          float a[9]; for (int j = 0; j < 9; ++j) a[j] = 0.f;
          for (int k = kc * 64; k < kc * 64 + 64; ++k) { const float w = wa[((size_t)l * 1024 + k) * 6144 + n];
#pragma unroll
              for (int j = 0; j < 8; ++j) a[j] += siluf_(c[j * 1024 + k]) * w;
              a[8] += siluf_(cc[k]) * w; }
          for (int j = 0; j < 9; ++j) modp[(((size_t)kc * 2 + l) * 9 + j) * 6144 + n] = a[j]; } }
    { float* rc = (float*)(p.ws + WS_ROPE); float* rs = rc + 4096 * 32;
      for (size_t i = gt; i < (size_t)4096 * 32; i += gn) { const int t = (int)(i >> 5), j = (int)(i & 31); const float inv = powf(10000.0f, -(float)(j & 15) / 16.0f);
          const float pos = (j < 16) ? (float)(t >> 6) : (float)(t & 63); const float ang = pos * inv; float s, c2; sincosf(ang, &s, &c2); rc[i] = c2; rs[i] = s; } }
    { bf16_t* cm = (bf16_t*)(p.ws + WS_CMAT); bf16_t* sm = (bf16_t*)(p.ws + WS_SMAT);
      for (size_t i = gt; i < (size_t)2048 * 2048; i += gn) { const int tp = (int)(i >> 11), k = (int)(i & 2047); const int m = (tp * k) & 4095; float s, c2; sincospif((float)m * (1.0f / 2048.0f), &s, &c2);
          cm[i] = f2bf(c2); sm[i] = f2bf(s); } }
}
__device__ void ph_modreduce(const Params& p) {
    const size_t gt = (size_t)blockIdx.x * 512 + get_tid(), gn = (size_t)gridDim.x * 512;
    const float* modp = (const float*)(p.ws + WS_MODP); float* mod = (float*)(p.ws + WS_MOD); const float* ba = IN(5);
    for (size_t i = gt; i < (size_t)2 * 9 * 6144; i += gn) { const int n = (int)(i % 6144); const int l = (int)(i / (9 * 6144));
        float a = ba[(size_t)l * 6144 + n]; for (int kc = 0; kc < 16; ++kc) a += modp[(size_t)kc * 2 * 9 * 6144 + i]; mod[i] = a; }
}
__device__ void tconv(const float* src, int lds_, int K, int N, bf16_t* dst, int ldd, bool win_scale, float* tile) {
    const int tid = get_tid(); const int ntn = N / 64, ntiles = (K / 64) * ntn;
    for (int id = blockIdx.x; id < ntiles; id += gridDim.x) {
        const int k0 = (id / ntn) * 64, n0 = (id % ntn) * 64;
        float sc = 1.0f; if (win_scale && ((n0 < 256) || (n0 >= 1280 && n0 < 1536))) sc = 0.125f;
        { const int j = tid & 63, i0 = tid >> 6;
#pragma unroll
          for (int q = 0; q < 8; ++q) { const int k = i0 + 8 * q; tile[k * 65 + j] = src[(size_t)(k0 + k) * lds_ + n0 + j] * sc; } }
        __syncthreads();
        { const int n = tid >> 3, kk = (tid & 7) * 8; float v[8];
#pragma unroll
          for (int q = 0; q < 8; ++q) v[q] = tile[(kk + q) * 65 + n];
          u32x4 w; w.x = cvt_pk_bf16(v[0], v[1]); w.y = cvt_pk_bf16(v[2], v[3]); w.z = cvt_pk_bf16(v[4], v[5]); w.w = cvt_pk_bf16(v[6], v[7]);
          *(u32x4*)(dst + (size_t)(n0 + n) * ldd + k0 + kk) = w; }
        __syncthreads();
    }
}
__device__ void ph_wconv(const Params& p, int l, float* shf) {
    bf16_t* w1t = (bf16_t*)(p.ws + WS_W1T);
    tconv(IN(8) + (size_t)l * 1024 * 3072, 3072, 1024, 2816, w1t, 1024, true, shf);
    for (int i = 0; i < 4; ++i) tconv(IN(28) + ((size_t)l * 4 + i) * 1024 * 1024, 1024, 1024, 1024, (bf16_t*)(p.ws + WS_WGT) + (size_t)i * 1024 * 1024, 1024, false, shf);
    for (int i = 0; i < 4; ++i) tconv(IN(30) + ((size_t)l * 4 + i) * 256 * 1024, 1024, 256, 1024, (bf16_t*)(p.ws + WS_WBRT) + (size_t)i * 1024 * 256, 256, false, shf);
    tconv(IN(31) + (size_t)l * 1024 * 1024, 1024, 1024, 1024, (bf16_t*)(p.ws + WS_WOUTT), 1024, false, shf);
    tconv(IN(32) + (size_t)l * 1024 * 5632, 5632, 1024, 5632, (bf16_t*)(p.ws + WS_WUPT), 1024, false, shf);
    tconv(IN(35) + (size_t)l * 2816 * 1024, 1024, 2816, 1024, (bf16_t*)(p.ws + WS_WDNT), 2816, false, shf);
    const size_t gt = (size_t)blockIdx.x * 512 + get_tid(), gn = (size_t)gridDim.x * 512;
    const float* win = IN(8) + (size_t)l * 1024 * 3072; const float* mu = IN(15) + (size_t)l * 3 * 1024;
    for (size_t i = gt; i < (size_t)NAUX * 1024; i += gn) {
        const int nn = (int)(i >> 10), k = (int)(i & 1023); float v = 0.f;
        if (nn < 512) { const int ri = nn >> 8, h = (nn >> 6) & 3, cp = nn & 63; const float* wr = win + (size_t)k * 3072 + 2816 + h * 64; float a = 0.f;
            for (int c = 0; c < 64; ++c) { const int m = (c * cp) & 63; float s, c2; sincospif((float)m * (1.0f / 32.0f), &s, &c2); a += wr[c] * (ri ? -s : c2); } v = a; }
        else if (nn < 544) { const int j = nn - 512, dr = j >> 4, jj = j & 15; v = IN(9)[(((size_t)l * 2 + dr) * 1024 + k) * 16 + jj]; }
        else if (nn < 672) { const int j = nn - 544, dr = j >> 6, jj = j & 63; v = IN(17)[(((size_t)l * 2 + dr) * 1024 + k) * 64 + jj]; }
        else if (nn < 800) { const int j = nn - 672, dr = j >> 6, jj = j & 63; v = mu[k] * IN(17)[(((size_t)l * 2 + dr) * 1024 + k) * 64 + jj]; }
        else if (nn < 928) { const int j = nn - 800, dr = j >> 6, jj = j & 63; v = IN(20)[(((size_t)l * 2 + dr) * 1024 + k) * 64 + jj]; }
        else if (nn < 1056) { const int j = nn - 928, dr = j >> 6, jj = j & 63; v = mu[1024 + k] * IN(20)[(((size_t)l * 2 + dr) * 1024 + k) * 64 + jj]; }
        else if (nn < 1216) { const int jj = nn - 1056; v = IN(22)[((size_t)l * 1024 + k) * 160 + jj]; }
        else if (nn < 1376) { const int jj = nn - 1216; v = mu[2048 + k] * IN(22)[((size_t)l * 1024 + k) * 160 + jj]; }
        w1t[(size_t)(2816 + nn) * 1024 + k] = f2bf(v);
    }
    bf16_t* w2t = (bf16_t*)(p.ws + WS_W2T);
    for (size_t i = gt; i < (size_t)N2 * K2; i += gn) {
        const int n = (int)(i >> 9), k = (int)(i & 511); const int grp = n >> 8, c = n & 255; float v = 0.f;
        if (grp < 2) { const int kk = k - 64 * grp; if (kk >= 0 && kk < 64) v = IN(18)[(((size_t)l * 2 + grp) * 64 + kk) * 256 + c]; }
        else if (grp < 4) { const int d = grp - 2, kk = k - 128 - 64 * d; if (kk >= 0 && kk < 64) v = IN(21)[(((size_t)l * 2 + d) * 64 + kk) * 256 + c]; }
        else if (grp == 4) { const int kk = k - 256; if (kk >= 0 && kk < 160) v = IN(23)[((size_t)l * 160 + kk) * 256 + c]; }
        else { const int d = grp - 5, kk = k - 416 - 16 * d; if (kk >= 0 && kk < 16) v = IN(10)[(((size_t)l * 2 + d) * 16 + kk) * 256 + c]; }
        w2t[i] = f2bf(v);
    }
}

__device__ void ph_norm(const Params& p, int l, int half, int which, int nrows) {
    const int wv = get_tid() >> 6, lane = get_tid() & 63;
    const float* g = IN(which ? 7 : 6) + (size_t)l * 1024; const float* modl = (const float*)(p.ws + WS_MOD) + (size_t)l * 9 * 6144;
    bf16_t* hb = (bf16_t*)(p.ws + WS_HB);
    for (int r = blockIdx.x * 8 + wv; r < nrows; r += gridDim.x * 8) {
        int isctx, bl, t; rowinfo(r, isctx, bl, t); const int mb = isctx ? 8 : half * NHB + bl;
        const float* x = xrow_ptr(p, half, r); const float* sh = modl + (size_t)mb * 6144 + (which ? 3 : 0) * 1024; const float* sc = sh + 1024;
        f32x4 v[4]; float ss = 0.f;
#pragma unroll
        for (int q = 0; q < 4; ++q) { v[q] = *(const f32x4*)(x + q * 256 + lane * 4); ss += v[q][0] * v[q][0] + v[q][1] * v[q][1] + v[q][2] * v[q][2] + v[q][3] * v[q][3]; }
        ss = wave_sum(ss); const float rs = rsqrtf(ss * (1.0f / 1024.0f) + EPSF);
#pragma unroll
        for (int q = 0; q < 4; ++q) { const int c = q * 256 + lane * 4; const f32x4 gg = *(const f32x4*)(g + c), s1 = *(const f32x4*)(sc + c), s0 = *(const f32x4*)(sh + c);
            float o[4];
#pragma unroll
            for (int j = 0; j < 4; ++j) o[j] = v[q][j] * rs * gg[j] * (1.0f + s1[j]) + s0[j];
            u32x2 w; w.x = cvt_pk_bf16(o[0], o[1]); w.y = cvt_pk_bf16(o[2], o[3]); *(u32x2*)(hb + (size_t)r * 1024 + c) = w; }
    }
}
__device__ void ph_final(const Params& p) {
    const int wv = get_tid() >> 6, lane = get_tid() & 63; const float* g = IN(36);
    for (int r = blockIdx.x * 8 + wv; r < NBATCH * TL; r += gridDim.x * 8) {
        float* x = p.out + (size_t)r * DM; f32x4 v[4]; float ss = 0.f;
#pragma unroll
        for (int q = 0; q < 4; ++q) { v[q] = *(const f32x4*)(x + q * 256 + lane * 4); ss += v[q][0] * v[q][0] + v[q][1] * v[q][1] + v[q][2] * v[q][2] + v[q][3] * v[q][3]; }
        ss = wave_sum(ss); const float rs = rsqrtf(ss * (1.0f / 1024.0f) + EPSF);
#pragma unroll
        for (int q = 0; q < 4; ++q) { const int c = q * 256 + lane * 4; const f32x4 gg = *(const f32x4*)(g + c); f32x4 o;
#pragma unroll
            for (int j = 0; j < 4; ++j) o[j] = v[q][j] * rs * gg[j];
            *(f32x4*)(x + c) = o; }
    }
}

__device__ void ph_prepA(const Params& p, float* shf) {
    const int tid = get_tid(), wv = tid >> 6, lane = tid & 63;
    const bf16_t* paux = (const bf16_t*)(p.ws + WS_PAUX); bf16_t* a2 = (bf16_t*)(p.ws + WS_A2);
    for (int r = blockIdx.x * 8 + wv; r < RH; r += gridDim.x * 8) {
        int isctx, bl, t; rowinfo(r, isctx, bl, t); const int slen = isctx ? TC : TL; const bool hp = t > 0, hn = t < slen - 1;
        const bf16_t* pc = paux + (size_t)r * NAUX; const bf16_t* pp = pc - NAUX; const bf16_t* pn = pc + NAUX;
#pragma unroll
        for (int q = 0; q < 8; ++q) { const int j = lane + 64 * q; float v = 0.f;
            if (j < 416) { int ph, qm; if (j < 128) { ph = 544 + j; qm = 672 + j; } else if (j < 256) { ph = 800 + (j - 128); qm = 928 + (j - 128); } else { ph = 1056 + (j - 256); qm = 1216 + (j - 256); }
                const float s = bf2f(pc[ph]) + 0.5f * ((hp ? bf2f(pp[qm]) : 0.f) + (hn ? bf2f(pn[qm]) : 0.f)) - bf2f(pc[qm]);
                v = (j < 128) ? tanhf(s) : ((j < 256) ? s : sigmoidf_(s)); }
            else if (j < 448) v = bf2f(pc[512 + (j - 416)]);
            a2[(size_t)r * K2 + j] = f2bf(v); }
    }
    bf16_t* ert = (bf16_t*)(p.ws + WS_ERT); bf16_t* oit = (bf16_t*)(p.ws + WS_OIT);
    for (int id = blockIdx.x; id < 1024; id += gridDim.x) {
        const int kt = id & 31, ntile = (id >> 5) & 3, ri = (id >> 7) & 1, bl = id >> 8; const int k0 = kt * 64, n0 = ntile * 64;
        { const int j = tid & 63, i0 = tid >> 6;
#pragma unroll
          for (int q = 0; q < 8; ++q) { const int i = i0 + 8 * q, k = k0 + i; const float x = bf2f(paux[(size_t)(bl * TL + k) * NAUX + ri * 256 + n0 + j]);
              float xm = 0.f; if (k > 0) xm = bf2f(paux[(size_t)(bl * TL + (4096 - k)) * NAUX + ri * 256 + n0 + j]);
              shf[i * 65 + j] = ri ? (x - xm) : (x + xm); } }
        __syncthreads();
        { const int n = tid >> 3, kk = (tid & 7) * 8; float v[8];
#pragma unroll
          for (int q = 0; q < 8; ++q) v[q] = shf[(kk + q) * 65 + n];
          u32x4 w; w.x = cvt_pk_bf16(v[0], v[1]); w.y = cvt_pk_bf16(v[2], v[3]); w.z = cvt_pk_bf16(v[4], v[5]); w.w = cvt_pk_bf16(v[6], v[7]);
          *(u32x4*)((ri ? oit : ert) + (size_t)(bl * 256 + n0 + n) * 2048 + k0 + kk) = w; }
        __syncthreads();
    }
    const size_t gt = (size_t)blockIdx.x * 512 + tid, gn = (size_t)gridDim.x * 512;
    { bf16_t* gc = (bf16_t*)(p.ws + WS_GC); for (size_t i = gt; i < (size_t)RCH * 512; i += gn) { const int rc = (int)(i >> 9), c = (int)(i & 511); gc[i] = paux[(size_t)(RLH + rc) * NAUX + c]; } }
    { float* g2 = (float*)(p.ws + WS_GR2048); for (size_t i = gt; i < (size_t)NHB * 256; i += gn) { const int bl = (int)(i >> 8), n = (int)(i & 255); g2[i] = bf2f(paux[(size_t)(bl * TL + 2048) * NAUX + n]); } }
    { float* ny = (float*)(p.ws + WS_NYQP); for (size_t i = gt; i < (size_t)NHB * 32 * 256; i += gn) { const int n = (int)(i & 255), s = (int)((i >> 8) & 31), bl = (int)(i >> 13); float a = 0.f;
          for (int tt = 0; tt < 128; ++tt) { const int t = s * 128 + tt; const float x = bf2f(paux[(size_t)(bl * TL + t) * NAUX + n]); a += (tt & 1) ? -x : x; } ny[i] = a; } }
}

__device__ void ph_prepB(const Params& p, int l) {
    const int wv = get_tid() >> 6, d = get_tid() & 63;
    bf16_t* pm = (bf16_t*)(p.ws + WS_PMAIN); const bf16_t* pre2 = (const bf16_t*)(p.ws + WS_PRE2);
    bf16_t* oR = (bf16_t*)(p.ws + WS_RW_R); bf16_t* oV = (bf16_t*)(p.ws + WS_RW_V); bf16_t* oN = (bf16_t*)(p.ws + WS_RW_NKK);
    bf16_t* oB = (bf16_t*)(p.ws + WS_RW_B); bf16_t* oKD = (bf16_t*)(p.ws + WS_RW_KD); float* oW = (float*)(p.ws + WS_RW_W); float* oGA = (float*)(p.ws + WS_GA);
    bf16_t* oG = (bf16_t*)(p.ws + WS_GRW); float* oBo = (float*)(p.ws + WS_BONUS);
    const float* cw = IN(14) + (size_t)l * 3 * 768; const float* ropec = (const float*)(p.ws + WS_ROPE); const float* ropes = ropec + 4096 * 32;
    const size_t AE = (size_t)RH * 256;
    for (int it = blockIdx.x * 8 + wv; it < RH * 4; it += gridDim.x * 8) {
        const int r = it >> 2, h = it & 3, c = h * 64 + d;
        int isctx, bl, t; rowinfo(r, isctx, bl, t); const int slen = isctx ? TC : TL; const bool hp = t > 0, hn = t < slen - 1;
        const bf16_t* pc = pm + (size_t)r * NMAIN; const bf16_t* pp = pc - NMAIN; const bf16_t* pn = pc + NMAIN;
        float rkv[3];
#pragma unroll
        for (int j = 0; j < 3; ++j) { const int col = 2048 + j * 256 + c; const int wc = j * 256 + c;
            rkv[j] = (hp ? bf2f(pp[col]) : 0.f) * cw[wc] + bf2f(pc[col]) * cw[768 + wc] + (hn ? bf2f(pn[col]) : 0.f) * cw[1536 + wc]; }
        const float rr = rkv[0], kc = rkv[1], vc = rkv[2];
        float kk = kc * IN(24)[l * 256 + c]; const float ssq = wave_sum(kk * kk); kk *= rsqrtf(ssq + EPSF);
        const float ka = IN(25)[l * 256 + c], rk = IN(26)[l * 256 + c];
        const bf16_t* q2 = pre2 + (size_t)r * N2; float bonus = 0.f; const size_t o = (size_t)r * 256 + c;
#pragma unroll
        for (int dr = 0; dr < 2; ++dr) {
            const float u = IN(16)[(l * 2 + dr) * 256 + c] + bf2f(q2[dr * 256 + c]);
            const float wraw = -softplusf_(-u) - 0.5f; const float dec = __expf(-__expf(wraw));
            const float a = sigmoidf_(IN(19)[(l * 2 + dr) * 256 + c] + bf2f(q2[512 + dr * 256 + c]));
            const float kd = kc * (1.0f + (a - 1.0f) * ka); const float bb = kk * a;
            bonus += wave_sum(rr * kd * rk) * vc;
            oW[dr * AE + o] = dec; oB[dr * AE + o] = f2bf(bb); oKD[dr * AE + o] = f2bf(kd);
            const float z = bf2f(q2[1280 + dr * 256 + c]) + IN(11)[(l * 2 + dr) * 256 + c];
            oGA[dr * AE + o] = __expf(-softplusf_(-z) * (1.0f / 16.0f));
        }
        oR[o] = f2bf(rr); oV[o] = f2bf(vc); oN[o] = f2bf(-kk); oBo[o] = bonus; oG[o] = q2[1024 + c];
        if (!isctx) {
            const float cs = ropec[t * 32 + (d & 31)], sn = ropes[t * 32 + (d & 31)];
#pragma unroll
            for (int j = 0; j < 2; ++j) { bf16_t* e = pm + (size_t)r * NMAIN + 1024 + j * 256 + c; const float x = bf2f(*e); const float y = __shfl_xor(x, 32, 64);
                const float ov = (d < 32) ? (x * cs - y * sn) : (y * sn + x * cs); *e = f2bf(ov); }
        }
    }
}

template <int MIX  >
__device__ void scan_body(const Params& p, int seq, int rhalf, unsigned char* shm) {
    const int tid = get_tid(), wv = tid >> 6, lane = tid & 63, rrow = lane >> 4, ks = lane & 15;
    const int bl = seq >> 3, h = (seq >> 1) & 3, dr = seq & 1;
    const int rowl = wv * 4 + rrow;
    const int row = rhalf * 32 + rowl;
    const size_t AE = (size_t)RH * 256;
    float* buf = (float*)shm;
    float* ybuf = (float*)(shm + 98304);
    const int sst = tid >> 4, sc4 = (tid & 15) * 4;
    const bf16_t* pm = (const bf16_t*)(p.ws + WS_PMAIN);
    float gam = 1.0f; if (MIX == 2) { const int hh = dr ? (3 - h) : h; gam = 1.0f - exp2f(-5.0f - (float)hh); }
    f32x4 st = (f32x4){0.f, 0.f, 0.f, 0.f};
    f32x4 rg[6];
    constexpr int NCH = (TC + TL) / 32;
    auto tokrow = [&](int pidx) -> int { if (pidx < TC) { const int tt = dr ? (TC - 1 - pidx) : pidx; return RLH + bl * TC + tt; } const int q = pidx - TC; const int tt = dr ? (TL - 1 - q) : q; return bl * TL + tt; };
    auto ld_bf4 = [&](const bf16_t* base, size_t off) -> f32x4 { const u32x2 w = *(const u32x2*)(base + off); f32x4 v; v[0] = __uint_as_float(w.x << 16); v[1] = __uint_as_float(w.x & 0xFFFF0000u); v[2] = __uint_as_float(w.y << 16); v[3] = __uint_as_float(w.y & 0xFFFF0000u); return v; };
    auto load_regs = [&](int ch) {
        const int r = tokrow(ch * 32 + sst); const int c = h * 64 + sc4;
        if (MIX == 0) { const size_t o = (size_t)r * 256 + c;
            rg[0] = ld_bf4((const bf16_t*)(p.ws + WS_RW_NKK), o); rg[1] = *(const f32x4*)((const float*)(p.ws + WS_RW_W) + dr * AE + o);
            rg[2] = ld_bf4((const bf16_t*)(p.ws + WS_RW_B), dr * AE + o); rg[3] = ld_bf4((const bf16_t*)(p.ws + WS_RW_KD), dr * AE + o);
            rg[4] = ld_bf4((const bf16_t*)(p.ws + WS_RW_R), o); rg[5] = ld_bf4((const bf16_t*)(p.ws + WS_RW_V), o);
        } else if (MIX == 1) { const size_t o = (size_t)r * NMAIN + c;
            rg[1] = *(const f32x4*)((const float*)(p.ws + WS_GA) + dr * AE + (size_t)r * 256 + c);
            rg[3] = ld_bf4(pm, o + 256); rg[4] = ld_bf4(pm, o); rg[5] = ld_bf4(pm, o + 512);
        } else { const size_t o = (size_t)r * NMAIN + 1024 + c;
            rg[3] = ld_bf4(pm, o + 256); rg[4] = ld_bf4(pm, o); rg[5] = ld_bf4(pm, o + 512); }
    };
    auto store_lds = [&](int b) {
        float* bb = buf + (size_t)b * 6 * 2048 + sst * 64 + sc4;
        if (MIX == 0) { *(f32x4*)(bb) = rg[0]; *(f32x4*)(bb + 2 * 2048) = rg[2]; }
        if (MIX != 2) *(f32x4*)(bb + 1 * 2048) = rg[1];
        *(f32x4*)(bb + 3 * 2048) = rg[3]; *(f32x4*)(bb + 4 * 2048) = rg[4]; *(f32x4*)(bb + 5 * 2048) = rg[5];
    };
    bf16_t* outb = (bf16_t*)(p.ws + WS_SO) + (size_t)((MIX == 0 ? 4 : (MIX == 1 ? 0 : 2)) + dr) * AE;
    load_regs(0); store_lds(0); __syncthreads();
    for (int ch = 0; ch < NCH; ++ch) {
        if (ch + 1 < NCH) load_regs(ch + 1);
        const float* bb = buf + (size_t)(ch & 1) * 6 * 2048; float* yb = ybuf + (ch & 1) * 1024;
#pragma unroll 2
        for (int s = 0; s < 32; ++s) {
            const float* bs = bb + s * 64 + ks * 4;
            const f32x4 kd = *(const f32x4*)(bs + 3 * 2048), rv = *(const f32x4*)(bs + 4 * 2048); const float vv = bb[5 * 2048 + s * 64 + row];
            if (MIX == 0) {
                const f32x4 a = *(const f32x4*)(bs), w = *(const f32x4*)(bs + 1 * 2048), b = *(const f32x4*)(bs + 2 * 2048);
                float sa = st[0] * a[0] + st[1] * a[1] + st[2] * a[2] + st[3] * a[3]; sa = row16_allsum(sa);
#pragma unroll
                for (int j = 0; j < 4; ++j) st[j] = st[j] * w[j] + (sa * b[j] + vv * kd[j]);
            } else if (MIX == 1) {
                const f32x4 w = *(const f32x4*)(bs + 1 * 2048);
#pragma unroll
                for (int j = 0; j < 4; ++j) st[j] = st[j] * w[j] + vv * kd[j];
            } else {
#pragma unroll
                for (int j = 0; j < 4; ++j) st[j] = st[j] * gam + vv * kd[j];
            }
            float y = st[0] * rv[0] + st[1] * rv[1] + st[2] * rv[2] + st[3] * rv[3]; y = row16_allsum(y);
            if (ks == 0) yb[s * 32 + rowl] = y;
        }
        if (ch + 1 < NCH) store_lds((ch + 1) & 1);
        __syncthreads();
        { const int s = tid >> 4, r2 = (tid & 15) * 2; const int r = tokrow(ch * 32 + s);
          const unsigned w = cvt_pk_bf16(yb[s * 32 + r2], yb[s * 32 + r2 + 1]);
          *(unsigned*)(outb + (size_t)r * 256 + h * 64 + rhalf * 32 + r2) = w; }
    }
}

__device__ void ph_branch(const Params& p, int l, int nrows, float* shf) {
    const int tid = get_tid(), wv = tid >> 6, d = tid & 63;
    if (tid < 256) { float s, c2; sincospif((float)tid * (1.0f / 128.0f), &s, &c2); shf[tid] = c2; shf[256 + tid] = s; }
    __syncthreads();
    const bf16_t* pm = (const bf16_t*)(p.ws + WS_PMAIN); const bf16_t* so = (const bf16_t*)(p.ws + WS_SO); const size_t AE = (size_t)RH * 256;
    const bf16_t* grw = (const bf16_t*)(p.ws + WS_GRW); const float* bon = (const float*)(p.ws + WS_BONUS);
    const float* fc = (const float*)(p.ws + WS_FC); const float* fs = (const float*)(p.ws + WS_FS); const float* g2048 = (const float*)(p.ws + WS_GR2048);
    const float* nyq = (const float*)(p.ws + WS_NYQP); const bf16_t* gc = (const bf16_t*)(p.ws + WS_GC);
    bf16_t* outs = (bf16_t*)(p.ws + WS_OUTS);
    for (int it = blockIdx.x * 8 + wv; it < nrows * 4; it += gridDim.x * 8) {
        const int r = it >> 2, h = it & 3, c = h * 64 + d; const size_t o = (size_t)r * 256 + c;
        int isctx, bl, t; rowinfo(r, isctx, bl, t);
        const bf16_t* pc = pm + (size_t)r * NMAIN;
        float og = bf2f(so[0 * AE + o]) + bf2f(so[1 * AE + o]);
        { const float ms = wave_sum(og * og) * (1.0f / 64.0f); og = og * rsqrtf(ms + EPSF) * IN(12)[l * 256 + c] * siluf_(bf2f(pc[768 + c])); }
        float orr = bf2f(so[2 * AE + o]) + bf2f(so[3 * AE + o]);
        { const float mean = wave_sum(orr) * (1.0f / 64.0f); orr -= mean; const float var = wave_sum(orr * orr) * (1.0f / 64.0f); orr = orr * rsqrtf(var + EPSF) * IN(13)[l * 256 + c] * siluf_(bf2f(pc[1792 + c])); }
        float ow = bf2f(so[4 * AE + o]) + bf2f(so[5 * AE + o]);
        { const float mean = wave_sum(ow) * (1.0f / 64.0f); ow -= mean; const float var = wave_sum(ow * ow) * (1.0f / 64.0f); ow = (ow * rsqrtf(var + EPSF) * IN(27)[l * 256 + c] + bon[o]) * bf2f(grw[o]); }
        float of;
        if (!isctx) {
            const float sg = (t & 1) ? -1.0f : 1.0f; const int col = bl * 256 + c;
            if (t < 2048) of = fc[(size_t)t * 1024 + col] + fs[(size_t)t * 1024 + col] + sg * g2048[col];
            else if (t == 2048) { float a = 0.f; for (int s = 0; s < 32; ++s) a += nyq[((size_t)bl * 32 + s) * 256 + c]; of = a; }
            else { const int t2 = 4096 - t; of = fc[(size_t)t2 * 1024 + col] - fs[(size_t)t2 * 1024 + col] + sg * g2048[col]; }
            of *= (1.0f / 512.0f);
        } else {
            float a = 0.f; const bf16_t* gb = gc + (size_t)bl * 256 * 512 + c;
            for (int tt = 0; tt < 256; ++tt) { const int m = (tt * t) & 255; a += shf[m] * bf2f(gb[(size_t)tt * 512]) + shf[256 + m] * bf2f(gb[(size_t)tt * 512 + 256]); }
            of = a * (1.0f / 128.0f);
        }
        bf16_t* orow = outs + (size_t)r * 1024 + c;
        orow[0] = f2bf(og); orow[256] = f2bf(orr); orow[512] = f2bf(ow); orow[768] = f2bf(of);
    }
}

__device__ void ph_act(const Params& p, int l, int nrows) {
    const size_t gt = (size_t)blockIdx.x * 512 + get_tid(), gn = (size_t)gridDim.x * 512;
    const bf16_t* U = (const bf16_t*)(p.ws + WS_U); bf16_t* A = (bf16_t*)(p.ws + WS_ACT);
    const float* cw = IN(33) + (size_t)l * 3 * DFF; const float* cb = IN(34) + (size_t)l * DFF;
    const size_t items = (size_t)nrows * 352;
    for (size_t it = gt; it < items; it += gn) {
        const int r = (int)(it / 352), j0 = (int)(it % 352) * 8;
        int isctx, bl, t; rowinfo(r, isctx, bl, t); const int slen = isctx ? TC : TL; const bool hp = t > 0, hn = t < slen - 1;
        const bf16_t* uc = U + (size_t)r * 5632 + j0;
        const u32x4 z4 = (u32x4){0u, 0u, 0u, 0u};
        const u32x4 ac = *(const u32x4*)uc, ap = hp ? *(const u32x4*)(uc - 5632) : z4, an = hn ? *(const u32x4*)(uc + 5632) : z4, uu = *(const u32x4*)(uc + 2816);
        float o[8];
#pragma unroll
        for (int j = 0; j < 8; ++j) { const unsigned wcur = ac[j >> 1], wp = ap[j >> 1], wn = an[j >> 1], wu = uu[j >> 1];
            const float xc = (j & 1) ? __uint_as_float(wcur & 0xFFFF0000u) : __uint_as_float(wcur << 16), xp = (j & 1) ? __uint_as_float(wp & 0xFFFF0000u) : __uint_as_float(wp << 16),
                        xn = (j & 1) ? __uint_as_float(wn & 0xFFFF0000u) : __uint_as_float(wn << 16), xu = (j & 1) ? __uint_as_float(wu & 0xFFFF0000u) : __uint_as_float(wu << 16);
            const float a = xp * cw[j0 + j] + xc * cw[DFF + j0 + j] + xn * cw[2 * DFF + j0 + j] + cb[j0 + j];
            o[j] = siluf_(a) * xu; }
        u32x4 w; w.x = cvt_pk_bf16(o[0], o[1]); w.y = cvt_pk_bf16(o[2], o[3]); w.z = cvt_pk_bf16(o[4], o[5]); w.w = cvt_pk_bf16(o[6], o[7]);
        *(u32x4*)(A + (size_t)r * DFF + j0) = w;
    }
}

#ifndef SUBMASK
#define SUBMASK 0x3FFF
#define ALLSTEPS 1
#endif
#define ON(s) (((SUBMASK) >> (s)) & 1)
constexpr int STEPS_PER_PASS = 14, NSTEPS = 2 + 4 * STEPS_PER_PASS + 1;

__device__ __forceinline__ void run_step(const Params& p, int step, unsigned char* shm) {
    float* shf = (float*)shm; LAS unsigned char* lds = (LAS unsigned char*)shm;
    const int G = gridDim.x, c = blockIdx.x;
#ifdef ALLSTEPS
    if (step == 0) { ph_setup(p, shf); return; }
    if (step == 1) { ph_modreduce(p); ph_wconv(p, 0, shf); return; }
    if (step == NSTEPS - 1) { ph_final(p); return; }
#endif
    const int ps = step - 2, pass = ps / STEPS_PER_PASS, sub = ps % STEPS_PER_PASS, l = pass >> 1, half = pass & 1;
    const bool need_ctx = (l == 0); const int Mpost = need_ctx ? RH : RLH;
    const float* modl = (const float*)(p.ws + WS_MOD) + (size_t)l * 9 * 6144;
    Sched S; Prob P; EpiU E{}; bool do_gemm = false;
    E.xlat = p.out; E.xctx = (float*)(p.ws + WS_XCTX); E.half = half; E.modl = modl;
    switch (sub) {
    case 0: if (ON(0)) { if (l == 1 && half == 0) ph_wconv(p, 1, shf); ph_norm(p, l, half, 0, RH); } break;
    case 1: if (ON(1)) { S.init(RH, N1, 1, G, c); P = Prob{(const bf16_t*)(p.ws + WS_HB), (const bf16_t*)(p.ws + WS_W1T), 1024, 1024, 16, 0, 0};
        E.mode = 0; E.O = p.ws + WS_PMAIN; E.O2 = p.ws + WS_PAUX; do_gemm = true; } break;
    case 2: if (ON(2)) ph_prepA(p, shf); break;
    case 3: if (ON(3)) { S.init(RH, N2, 1, G, c); P = Prob{(const bf16_t*)(p.ws + WS_A2), (const bf16_t*)(p.ws + WS_W2T), K2, K2, K2 / 64, 0, 0};
        E.mode = 1; E.O = p.ws + WS_PRE2; E.ldc = N2; do_gemm = true; } break;
    case 4: if (ON(4)) ph_prepB(p, l); break;
    case 5: if (ON(5)) { if (c < NWG_SCAN) { const int seq = c / 6, rem = c % 6, mix = rem >> 1, rhalf = rem & 1;
#ifndef REP_SCAN
#define REP_SCAN 1
#endif
            for (int rep = 0; rep < REP_SCAN; ++rep) { __syncthreads();
            if (mix == 0) scan_body<0>(p, seq, rhalf, shm); else if (mix == 1) scan_body<1>(p, seq, rhalf, shm); else scan_body<2>(p, seq, rhalf, shm); }
        } else {
            S.init(2048, 1024, 2, G - NWG_SCAN, c - NWG_SCAN);
            P = Prob{(const bf16_t*)(p.ws + WS_CMAT), (const bf16_t*)(p.ws + WS_ERT), 2048, 2048, 32, (size_t)2048 * 2048, (size_t)1024 * 2048};
            E.mode = 5; E.O = p.ws + WS_FC; E.ldc = 1024; E.seg_stride = (size_t)2048 * 1024; do_gemm = true; } }
        break;
    case 6: if (ON(6)) ph_branch(p, l, Mpost, shf); break;
    case 7: if (ON(7)) { S.init(Mpost, 4096, 1, G, c); P = Prob{(const bf16_t*)(p.ws + WS_HB), (const bf16_t*)(p.ws + WS_WGT), 1024, 1024, 16, 0, 0};
        E.mode = 2; E.O = p.ws + WS_GBUF; E.ldc = 4096; E.bias = IN(29) + (size_t)l * 4096; do_gemm = true; } break;
    case 8: if (ON(8)) { S.init(Mpost, 1024, 4, G, c); P = Prob{(const bf16_t*)(p.ws + WS_OUTS), (const bf16_t*)(p.ws + WS_WBRT), 1024, 256, 4, 256, (size_t)1024 * 256};
        E.mode = 3; E.O = p.ws + WS_Z; E.O2 = p.ws + WS_GBUF; do_gemm = true; } break;
    case 9: if (ON(9)) { S.init(Mpost, 1024, 1, G, c); P = Prob{(const bf16_t*)(p.ws + WS_Z), (const bf16_t*)(p.ws + WS_WOUTT), 1024, 1024, 16, 0, 0};
        E.mode = 4; E.gidx = 2; do_gemm = true; } break;
    case 10: if (ON(10)) ph_norm(p, l, half, 1, Mpost); break;
    case 11: if (ON(11)) { S.init(Mpost, 5632, 1, G, c); P = Prob{(const bf16_t*)(p.ws + WS_HB), (const bf16_t*)(p.ws + WS_WUPT), 1024, 1024, 16, 0, 0};
        E.mode = 1; E.O = p.ws + WS_U; E.ldc = 5632; do_gemm = true; } break;
    case 12: if (ON(12)) ph_act(p, l, Mpost); break;
    case 13: if (ON(13)) { S.init(Mpost, 1024, 1, G, c); P = Prob{(const bf16_t*)(p.ws + WS_ACT), (const bf16_t*)(p.ws + WS_WDNT), DFF, DFF, DFF / 64, 0, 0};
        E.mode = 4; E.gidx = 5; do_gemm = true; } break;
    }
#ifndef REP_GEMM
#define REP_GEMM 1
#endif
    if (do_gemm) { gemm_phase(lds, P, S, E);
        if (REP_GEMM > 1 && E.mode != 4 && sub != 5) for (int rep = 1; rep < REP_GEMM; ++rep) gemm_phase(lds, P, S, E); }
}


#define XB_TMO      128
#define XB_XCNT(j)  (256  + 64 * (j))
#define XB_XSUB(j)  (1280 + 64 * (j))
#define XB_XGEN(j)  (2304 + 64 * (j))
#define XB_TOP      3328
#define XB_TOPGEN   3392
#define XCD_BAR_WORDS 3456
#define XB_SPIN_CAP (1u << 22)
__device__ __forceinline__ unsigned xb_ld(unsigned* p)              { return __hip_atomic_load(p, __ATOMIC_RELAXED, __HIP_MEMORY_SCOPE_AGENT); }
__device__ __forceinline__ unsigned xb_add(unsigned* p, unsigned v) { return __hip_atomic_fetch_add(p, v, __ATOMIC_RELAXED, __HIP_MEMORY_SCOPE_AGENT); }
__device__ __forceinline__ unsigned xb_xcc_id() { return (unsigned)__builtin_amdgcn_s_getreg((3 << 11) | 20) & 0xFu; }
#define XB_SPIN(cond, bar) do { unsigned _sp = 0; while (cond) { __builtin_amdgcn_s_sleep(1); \
    if ((++_sp & 255u) == 0u) { if (xb_ld(&(bar)[XB_TMO])) break; if (_sp > XB_SPIN_CAP) { atomicAdd(&(bar)[XB_TMO], 1u); break; } } } } while (0)
struct XcdBarrier { unsigned* bar; unsigned x; volatile LAS unsigned* st; };
__device__ __forceinline__ XcdBarrier xcd_barrier_post(unsigned* bar, volatile LAS unsigned* st) {
    XcdBarrier b; b.bar = bar; b.x = xb_xcc_id(); b.st = st;
    if (threadIdx.x == 0) (void)xb_add(&bar[XB_XCNT(b.x)], 1u);
    return b;
}
__device__ __forceinline__ void xcd_barrier_complete(unsigned* bar, unsigned x, unsigned& nloc, unsigned& nx) {
    const unsigned G = gridDim.x * gridDim.y * gridDim.z;
    unsigned sum, cnt, mine, sp = 0u;
    for (;;) {
        sum = 0u; cnt = 0u; mine = 0u;
#pragma unroll
        for (unsigned j = 0; j < 16; ++j) { const unsigned c = xb_ld(&bar[XB_XCNT(j)]); sum += c; cnt += (c > 0u) ? 1u : 0u; mine = (j == x) ? c : mine; }
        if (sum == G) break;
        __builtin_amdgcn_s_sleep(1);
        if ((++sp & 255u) == 0u) { if (xb_ld(&bar[XB_TMO])) break; if (sp > XB_SPIN_CAP) { atomicAdd(&bar[XB_TMO], 1u); break; } }
    }
    nloc = mine > 0u ? mine : 1u; nx = cnt > 0u ? cnt : 1u;
}
__device__ __forceinline__ void xcd_barrier(const XcdBarrier& b) {
    asm volatile("s_waitcnt vmcnt(0)" ::: "memory");
    __syncthreads();
    if (threadIdx.x == 0) {
        unsigned* bar = b.bar;
        __builtin_amdgcn_s_waitcnt(0);
        unsigned nloc = b.st[0], nx = b.st[1];
        if (nloc == 0u) { xcd_barrier_complete(bar, b.x, nloc, nx); b.st[0] = nloc; b.st[1] = nx; }
        const unsigned old = xb_add(&bar[XB_XSUB(b.x)], 1u);
        const unsigned gen = old / nloc;
        if (old + 1u == (gen + 1u) * nloc) {
            __builtin_amdgcn_fence(__ATOMIC_RELEASE, "agent");
            asm volatile("s_waitcnt vmcnt(0)" ::: "memory");
            const unsigned og = xb_add(&bar[XB_TOP], 1u);
            const unsigned tg = og / nx;
            if (og + 1u == (tg + 1u) * nx) xb_add(&bar[XB_TOPGEN], 1u);
            else XB_SPIN(xb_ld(&bar[XB_TOPGEN]) == tg, bar);
            __builtin_amdgcn_fence(__ATOMIC_ACQUIRE, "agent");
            xb_add(&bar[XB_XGEN(b.x)], 1u);
            asm volatile("s_waitcnt vmcnt(0)" ::: "memory");
        } else {
            XB_SPIN(xb_ld(&bar[XB_XGEN(b.x)]) == gen, bar);
            __builtin_amdgcn_fence(__ATOMIC_ACQUIRE, "agent");
            asm volatile("s_waitcnt vmcnt(0)" ::: "memory");
        }
    }
    __syncthreads();
}

__global__ void __launch_bounds__(512, 2) fwd_megakernel(KArgs ka) {
    unsigned char* shm = g_shm;
    cg::grid_group grid = cg::this_grid();
    if (threadIdx.x == 0) {
#pragma unroll
        for (int i = 0; i < 37; ++i) ((const float**)(g_shm + 131072))[i] = ka.in[i];
        ((unsigned*)(g_shm + 131072 + 512))[0] = 0u; ((unsigned*)(g_shm + 131072 + 512))[1] = 0u;
    }
    __syncthreads();
    XcdBarrier xb = xcd_barrier_post((unsigned*)(ka.ws + WS_BAR), (volatile LAS unsigned*)((LAS unsigned char*)g_shm + 131072 + 512));
    for (int step = ka.step_lo; step < ka.step_hi; ++step) {
        Params p; p.out = ka.out; p.ws = ka.ws;
        asm volatile("" : "+s"(p.out), "+s"(p.ws));
        run_step(p, step, shm);
        if (step + 1 < ka.step_hi) { if (step == ka.step_lo) { __syncthreads(); grid.sync(); } else xcd_barrier(xb); }
    }
}

extern "C" void kernel_launch(void* const* d_in, const int* in_sizes, int n_in, void* d_out, int out_size, void* d_ws, size_t ws_size, hipStream_t stream) {
    static int grid = 0;
    if (grid == 0) {
        if (n_in != 37 || ws_size < WS_END) { fprintf(stderr, "kernel_launch: need 37 inputs and >= %zu bytes of workspace; got n_in %d, ws %zu\n", (size_t)WS_END, n_in, ws_size); grid = -1; return; }
        if (hipFuncSetAttribute((const void*)fwd_megakernel, hipFuncAttributeMaxDynamicSharedMemorySize, LDS_BYTES) != hipSuccess) { fprintf(stderr, "kernel_launch: hipFuncSetAttribute failed\n"); grid = -1; return; }
        int dev = 0, cus = 0, per_cu = 0; (void)hipGetDevice(&dev); (void)hipDeviceGetAttribute(&cus, hipDeviceAttributeMultiprocessorCount, dev);
        (void)hipOccupancyMaxActiveBlocksPerMultiprocessor(&per_cu, (const void*)fwd_megakernel, 512, LDS_BYTES);
        if (per_cu < 1 || cus != 256) fprintf(stderr, "kernel_launch: note: cus %d per_cu %d\n", cus, per_cu);
        (void)hipGetLastError();
        grid = 256;
    }
    if (grid < 0) return;
    if (hipMemsetAsync((char*)d_ws + WS_BAR, 0, 16384, stream) != hipSuccess) { fprintf(stderr, "kernel_launch: memset of barrier words failed\n"); return; }
    KArgs p{};
    for (int i = 0; i < 37; ++i) p.in[i] = (const float*)d_in[i];
    p.out = (float*)d_out; p.ws = (unsigned char*)d_ws;
#if USE_COOP
    p.step_lo = 0; p.step_hi = NSTEPS;
    void* args[] = {&p};
    hipError_t e = hipLaunchCooperativeKernel((const void*)fwd_megakernel, dim3(grid), dim3(512), args, LDS_BYTES, stream);
    if (e != hipSuccess) fprintf(stderr, "cooperative launch failed: %s\n", hipGetErrorString(e));
#else
    for (int s = 0; s < NSTEPS; ++s) { p.step_lo = s; p.step_hi = s + 1; hipLaunchKernelGGL(fwd_megakernel, dim3(grid), dim3(512), LDS_BYTES, stream, p); }
#endif
}
```

```cpp
#include <hip/hip_runtime.h>
#include <hip/hip_cooperative_groups.h>
#include <cstdio>
namespace cg = cooperative_groups;

#ifndef USE_COOP
#define USE_COOP 1
#endif

#define LAS __attribute__((address_space(3)))
typedef unsigned short bf16_t;
typedef short bf16x8 __attribute__((ext_vector_type(8)));
typedef float f32x4 __attribute__((ext_vector_type(4)));
typedef unsigned u32x4 __attribute__((ext_vector_type(4)));
typedef unsigned u32x2 __attribute__((ext_vector_type(2)));

constexpr int DM = 1024, NBATCH = 8, TL = 4096, TC = 256, NLAYER = 2;
constexpr int NHB = 4;
constexpr int RLH = NHB * TL;
constexpr int RCH = NHB * TC;
constexpr int RH = RLH + RCH;
constexpr int N1 = 4352, NMAIN = 2816, NAUX = 1536, K2 = 512, N2 = 1792, DFF = 2816;
constexpr float EPSF = 1e-6f;
constexpr int NWG_SCAN = 192;

constexpr size_t al256(size_t x) { return (x + 255) & ~(size_t)255; }
constexpr size_t WS_W1T = 0;
constexpr size_t WS_WGT = WS_W1T + (size_t)N1 * 1024 * 2;
constexpr size_t WS_W2T = WS_WGT + (size_t)4096 * 1024 * 2;
constexpr size_t WS_WBRT = WS_W2T + (size_t)N2 * K2 * 2;
constexpr size_t WS_WOUTT = WS_WBRT + (size_t)4 * 1024 * 256 * 2;
constexpr size_t WS_WUPT = WS_WOUTT + (size_t)1024 * 1024 * 2;
constexpr size_t WS_WDNT = WS_WUPT + (size_t)5632 * 1024 * 2;
constexpr size_t WS_CMAT = WS_WDNT + (size_t)1024 * 2816 * 2;
constexpr size_t WS_SMAT = WS_CMAT + (size_t)2048 * 2048 * 2;
constexpr size_t WS_MODP = WS_SMAT + (size_t)2048 * 2048 * 2;
constexpr size_t WS_MOD = WS_MODP + (size_t)16 * 2 * 9 * 6144 * 4;
constexpr size_t WS_ROPE = WS_MOD + (size_t)2 * 9 * 6144 * 4;
constexpr size_t WS_XCTX = WS_ROPE + (size_t)4096 * 32 * 2 * 4;
constexpr size_t WS_GR2048 = WS_XCTX + (size_t)2048 * 1024 * 4;
constexpr size_t WS_GC = WS_GR2048 + (size_t)4 * 256 * 4;
constexpr size_t WS_NYQP = WS_GC + (size_t)4 * 256 * 512 * 2;
constexpr size_t WS_ERT = WS_NYQP + (size_t)4 * 32 * 256 * 4;
constexpr size_t WS_OIT = WS_ERT + (size_t)1024 * 2048 * 2;
constexpr size_t WS_FC = WS_OIT + (size_t)1024 * 2048 * 2;
constexpr size_t WS_FS = WS_FC + (size_t)2048 * 1024 * 4;
constexpr size_t WS_BAR = WS_FS + (size_t)2048 * 1024 * 4;
constexpr size_t WS_HB = WS_BAR + 16384;
constexpr size_t WS_BIG = WS_HB + (size_t)RH * 1024 * 2;
constexpr size_t ARR2 = (size_t)RH * 256 * 2, ARR4 = (size_t)RH * 256 * 4;
constexpr size_t WS_PMAIN = WS_BIG;
constexpr size_t WS_PRE2 = WS_PMAIN + (size_t)RH * NMAIN * 2;
constexpr size_t WS_SCIN = WS_PRE2 + (size_t)RH * N2 * 2;
constexpr size_t WS_PAUX = WS_SCIN;
constexpr size_t WS_A2 = WS_PAUX + (size_t)RH * NAUX * 2;
constexpr size_t WS_RW_R = WS_SCIN, WS_RW_V = WS_RW_R + ARR2, WS_RW_NKK = WS_RW_V + ARR2, WS_RW_B = WS_RW_NKK + ARR2  ,
                 WS_RW_KD = WS_RW_B + 2 * ARR2  , WS_RW_W = WS_RW_KD + 2 * ARR2  , WS_GA = WS_RW_W + 2 * ARR4  ,
                 WS_GRW = WS_GA + 2 * ARR4, WS_BONUS = WS_GRW + ARR2, WS_SCIN_END = WS_BONUS + ARR4;
constexpr size_t WS_OUTS = WS_SCIN;
constexpr size_t WS_Z = WS_OUTS + (size_t)RH * 1024 * 2;
constexpr size_t WS_GBUF = WS_PMAIN;
constexpr size_t WS_U = WS_PMAIN;
constexpr size_t WS_ACT = WS_U + (size_t)RH * 5632 * 2;
constexpr size_t WS_SO = (WS_SCIN_END > WS_ACT + (size_t)RH * 2816 * 2) ? WS_SCIN_END : WS_ACT + (size_t)RH * 2816 * 2;
constexpr size_t WS_END = WS_SO + 6 * ARR2;
static_assert(WS_END <= (size_t)536870912, "workspace budget (4 x the largest tensor)");
static_assert(WS_Z + (size_t)RH * 1024 * 2 <= WS_GRW, "outs+z inside dead scan inputs");
static_assert(WS_GBUF + (size_t)RH * 4096 * 2 <= WS_SCIN, "gbuf fits");
static_assert(WS_A2 + (size_t)RH * K2 * 2 <= WS_SCIN_END, "a2 fits");

constexpr int LDS_BYTES = 131072 + 8192;

struct KArgs {
    const float* in[37];
    float* out;
    unsigned char* ws;
    int step_lo, step_hi;
};
struct Params { float* out; unsigned char* ws; };

extern __shared__ __attribute__((aligned(16))) unsigned char g_shm[];
#define IN(k) (((const float* const*)(g_shm + 131072))[k])

__device__ __forceinline__ int get_tid() { int t = threadIdx.x; asm volatile("" : "+v"(t)); return t; }
__device__ __forceinline__ float bf2f(bf16_t b) { return __uint_as_float(((unsigned)b) << 16); }
__device__ __forceinline__ bf16_t f2bf(float f) { unsigned u = __float_as_uint(f); u += 0x7FFFu + ((u >> 16) & 1u); return (bf16_t)(u >> 16); }
__device__ __forceinline__ unsigned cvt_pk_bf16(float lo, float hi) { unsigned r; asm volatile("v_cvt_pk_bf16_f32 %0, %1, %2" : "=v"(r) : "v"(lo), "v"(hi)); return r; }
__device__ __forceinline__ float sigmoidf_(float x) { return __builtin_amdgcn_rcpf(1.0f + __expf(-x)); }
__device__ __forceinline__ float siluf_(float x) { return x * sigmoidf_(x); }
__device__ __forceinline__ float softplusf_(float x) { return fmaxf(x, 0.f) + log1pf(__expf(-fabsf(x))); }
__device__ __forceinline__ float wave_sum(float v) {
#pragma unroll
    for (int o = 32; o > 0; o >>= 1) v += __shfl_xor(v, o, 64);
    return v;
}
template <int CTRL> __device__ __forceinline__ float dpp_f(float x) { return __int_as_float(__builtin_amdgcn_update_dpp(0, __float_as_int(x), CTRL, 0xF, 0xF, false)); }
__device__ __forceinline__ float row16_allsum(float x) {
    x += dpp_f<0x128>(x); x += dpp_f<0x124>(x); x += dpp_f<0x122>(x); x += dpp_f<0x121>(x); return x;
}
__device__ __forceinline__ void rowinfo(int r, int& isctx, int& bl, int& t) {
    if (r < RLH) { isctx = 0; bl = r >> 12; t = r & 4095; } else { const int rc = r - RLH; isctx = 1; bl = rc >> 8; t = rc & 255; }
}
__device__ __forceinline__ float* xrow_ptr(const Params& p, int half, int r) {
    int isctx, bl, t; rowinfo(r, isctx, bl, t); const int b = half * NHB + bl;
    return isctx ? ((float*)(p.ws + WS_XCTX) + ((size_t)b * TC + t) * DM) : (p.out + ((size_t)b * TL + t) * DM);
}

constexpr int BM = 256, BN = 128, BK = 64, HTB = 128 * BK * 2, STG = 3 * HTB, NXCD = 8, WGM = 8;
__device__ __forceinline__ int lds_byte(int r, int c) { const int st = (r >> 4) * 2 + (c >> 5), rr = r & 15, cc = c & 31, ob = rr * 64 + cc * 2; return st * 1024 + (ob ^ (((ob >> 9) & 1) << 5)); }
__device__ __forceinline__ void stage_rc(int b, int& R, int& C) { const int st = b / 1024, sb = b % 1024, swz = sb ^ (((sb >> 9) & 1) << 5); R = (st >> 1) * 16 + swz / 64; C = (st & 1) * 32 + (swz % 64) / 2; }
__device__ __forceinline__ int perm32(int rho) { const int n = rho >> 4, i = rho & 15; return 8 * (i >> 2) + 4 * n + (i & 3); }

struct Unit { int pm, pn, seg; };
struct Sched {
    int nM, nN, nseg, ntiles, G, c;
    __device__ void init(int M, int N, int nseg_, int G_, int c_) { nM = M / BM; nN = N / BN; nseg = nseg_; ntiles = nM * nN; G = G_; c = c_; }
    __device__ bool next(int i, Unit& u) const {
        const int ti = i / nseg; const long L = (long)ti * G + c; if (L >= ntiles) return false;
        u.seg = i - ti * nseg;
        int wgid = (int)L; { const int q = ntiles / NXCD, r = ntiles % NXCD, xcd = wgid % NXCD, off = wgid / NXCD; wgid = (xcd < r ? xcd * (q + 1) : r * (q + 1) + (xcd - r) * q) + off; }
        const int nig = WGM * nN, gid = wgid / nig, fm = gid * WGM, gsz = (nM - fm) < WGM ? (nM - fm) : WGM;
        u.pm = fm + ((wgid % nig) % gsz); u.pn = (wgid % nig) / gsz; return true;
    }
};
struct Prob {
    const bf16_t* A; const bf16_t* Bt; int lda, ldb, nt; size_t a_seg, b_seg;
    __device__ __forceinline__ void ptrs(const Unit& u, const char*& a, const char*& b) const {
        a = (const char*)(A + (size_t)u.pm * BM * lda + (size_t)u.seg * a_seg);
        b = (const char*)(Bt + (size_t)u.pn * BN * ldb + (size_t)u.seg * b_seg);
    }
};

typedef f32x4 Acc[4][4];
__device__ __forceinline__ void acc_zero(Acc& acc) {
#pragma unroll
    for (int m = 0; m < 4; ++m)
#pragma unroll
        for (int n = 0; n < 4; ++n) acc[m][n] = (f32x4){0.f, 0.f, 0.f, 0.f};
}
struct EpiU;
__device__ __forceinline__ void epi_apply(const EpiU& E, int mode, const Acc& acc, const Unit& u, int wr, int wc, int fr, int fq);
__device__ __forceinline__ void epi_rescale(const EpiU& E, Acc& acc, const Unit& u, int wr, int wc, int fr, int fq);
__device__ __forceinline__ int epi_mode(const EpiU& E);

__device__ __forceinline__ void gemm_phase(LAS unsigned char* lds, const Prob P, const Sched& S, const EpiU& E) {
    const int tid = get_tid(), wid = __builtin_amdgcn_readfirstlane(tid >> 6), lane = tid & 63, wr = wid >> 1, wc = wid & 1, fr = lane & 15, fq = lane >> 4;
    const int nt = P.nt; const int mode = epi_mode(E); const bool perm = mode < 4;
    unsigned voffA[2], voffB[2];
#pragma unroll
    for (int i = 0; i < 2; ++i) { int R, C; stage_rc(tid * 16 + i * 8192, R, C); const int Rb = perm ? ((R & ~31) + perm32(R & 31)) : R;
        voffA[i] = (unsigned)(R * P.lda + C) * 2u; voffB[i] = (unsigned)(Rb * P.ldb + C) * 2u; }
    const size_t kstep = (size_t)(BK * 2), hstepA = (size_t)128 * P.lda * 2;
    const unsigned ldsw = (unsigned)wid * 1024u;
    const int aoff = (wr >> 1) * HTB + lds_byte((wr & 1) * 64 + fr, fq * 8), boff = 2 * HTB + lds_byte(wc * 64 + fr, fq * 8);
#define G_STAGE1(bufoff, gbase, voff) do { _Pragma("unroll") for (int _i = 0; _i < 2; ++_i) \
        __builtin_amdgcn_global_load_lds((const unsigned*)((const char*)(gbase) + (voff)[_i]), (LAS unsigned*)(lds + (bufoff) + ldsw + _i * 8192), 16, 0, 0); } while (0)
#define G_STAGE(s, ga, gb) do { G_STAGE1((s) * STG, ga, voffA); G_STAGE1((s) * STG + HTB, (ga) + hstepA, voffA); G_STAGE1((s) * STG + 2 * HTB, gb, voffB); } while (0)
#define G_WAIT_V(n) asm volatile("s_waitcnt vmcnt(" #n ")" ::: "memory")
#define G_BAR do { asm volatile("" ::: "memory"); __builtin_amdgcn_s_barrier(); asm volatile("" ::: "memory"); } while (0)
    Unit cur, nxt; int ui = 0;
    if (!S.next(0, cur)) return;
    Acc acc; acc_zero(acc);
    const char* cA; const char* cB; P.ptrs(cur, cA, cB);
    G_STAGE(0, cA, cB);
    for (;;) {
        const bool has_next = S.next(ui + 1, nxt);
        const char* nA = cA; const char* nB = cB; if (has_next) P.ptrs(nxt, nA, nB);
        for (int t = 0; t < nt; ++t) {
            const int s = t & 1;
            if (t + 1 < nt) { G_STAGE(s ^ 1, cA + (size_t)(t + 1) * kstep, cB + (size_t)(t + 1) * kstep); G_WAIT_V(6); }
            else if (has_next) { G_STAGE(s ^ 1, nA, nB); G_WAIT_V(6); }
            else { G_WAIT_V(0); }
            G_BAR;
            bf16x8 Af[4][2], Bf[4][2];
#pragma unroll
            for (int m = 0; m < 4; ++m)
#pragma unroll
                for (int k = 0; k < 2; ++k) Af[m][k] = *(const LAS bf16x8*)(lds + s * STG + aoff + m * 2048 + k * 1024);
#pragma unroll
            for (int n = 0; n < 4; ++n)
#pragma unroll
                for (int k = 0; k < 2; ++k) Bf[n][k] = *(const LAS bf16x8*)(lds + s * STG + boff + n * 2048 + k * 1024);
#pragma unroll
            for (int k = 0; k < 2; ++k)
#pragma unroll
                for (int m = 0; m < 4; ++m)
#pragma unroll
                    for (int n = 0; n < 4; ++n) acc[m][n] = __builtin_amdgcn_mfma_f32_16x16x32_bf16(Bf[n][k], Af[m][k], acc[m][n], 0, 0, 0);
            asm volatile("s_waitcnt lgkmcnt(0)" ::: "memory");
            G_BAR;
        }
        epi_apply(E, mode, acc, cur, wr, wc, fr, fq);
        if (mode == 3 && cur.seg < 3) epi_rescale(E, acc, cur, wr, wc, fr, fq); else acc_zero(acc);
        if (!has_next) break;
        cur = nxt; cA = nA; cB = nB; ++ui;
    }
    G_BAR;
#undef G_STAGE1
#undef G_STAGE
#undef G_WAIT_V
#undef G_BAR
}

__device__ __forceinline__ void unpack8(const u32x4 gc, float* g) {
    g[0] = __uint_as_float(gc.x << 16); g[1] = __uint_as_float(gc.x & 0xFFFF0000u); g[2] = __uint_as_float(gc.y << 16); g[3] = __uint_as_float(gc.y & 0xFFFF0000u);
    g[4] = __uint_as_float(gc.z << 16); g[5] = __uint_as_float(gc.z & 0xFFFF0000u); g[6] = __uint_as_float(gc.w << 16); g[7] = __uint_as_float(gc.w & 0xFFFF0000u);
}
struct EpiU {
    int mode;
    void* O; void* O2; int ldc; const float* bias; float* xlat; float* xctx; int half; const float* modl; int gidx; size_t seg_stride;
};
__device__ __forceinline__ int epi_mode(const EpiU& E) { return E.mode; }
__device__ __forceinline__ void epi_rescale(const EpiU& E, Acc& acc, const Unit& u, int wr, int wc, int fr, int fq) {
    const bf16_t* G = (const bf16_t*)E.O2; const int row0 = u.pm * BM + wr * 64 + fr, col0 = u.pn * BN + wc * 64 + 8 * fq, seg = u.seg;
#pragma unroll
    for (int m = 0; m < 4; ++m) { const size_t r = (size_t)(row0 + m * 16);
#pragma unroll
        for (int g2 = 0; g2 < 2; ++g2) { float g[8], h[8]; unpack8(*(const u32x4*)(G + r * 4096 + seg * 1024 + col0 + g2 * 32), g); unpack8(*(const u32x4*)(G + r * 4096 + (seg + 1) * 1024 + col0 + g2 * 32), h);
#pragma unroll
            for (int j = 0; j < 4; ++j) { acc[m][2 * g2][j] *= g[j] * __builtin_amdgcn_rcpf(h[j]); acc[m][2 * g2 + 1][j] *= g[4 + j] * __builtin_amdgcn_rcpf(h[4 + j]); } } }
}
__device__ __forceinline__ void epi_apply(const EpiU& E, int mode, const Acc& acc, const Unit& u, int wr, int wc, int fr, int fq) {
    const int row0 = u.pm * BM + wr * 64 + fr;
    if (mode < 4) {
        if (mode == 3 && u.seg != 3) return;
        bf16_t* base = (bf16_t*)E.O; int ld = E.ldc, colt = u.pn * BN;
        if (mode == 0) { if (u.pn < 22) { ld = NMAIN; } else { base = (bf16_t*)E.O2; ld = NAUX; colt = (u.pn - 22) * BN; } }
        if (mode == 3) ld = 1024;
        const int col0 = colt + wc * 64 + 8 * fq, gcol0 = u.pn * BN + wc * 64 + 8 * fq;
#pragma unroll
        for (int m = 0; m < 4; ++m) { const size_t r = (size_t)(row0 + m * 16);
#pragma unroll
            for (int g2 = 0; g2 < 2; ++g2) { f32x4 v0 = acc[m][2 * g2], v1 = acc[m][2 * g2 + 1];
                if (mode == 2) { const f32x4 b0 = *(const f32x4*)(E.bias + gcol0 + g2 * 32), b1 = *(const f32x4*)(E.bias + gcol0 + g2 * 32 + 4);
#pragma unroll
                    for (int j = 0; j < 4; ++j) { v0[j] = fmaxf(sigmoidf_(v0[j] + b0[j]), 1e-30f); v1[j] = fmaxf(sigmoidf_(v1[j] + b1[j]), 1e-30f); } }
                if (mode == 3) { float g[8]; unpack8(*(const u32x4*)((const bf16_t*)E.O2 + r * 4096 + 3 * 1024 + gcol0 + g2 * 32), g);
#pragma unroll
                    for (int j = 0; j < 4; ++j) { v0[j] *= g[j]; v1[j] *= g[4 + j]; } }
                u32x4 w; w.x = cvt_pk_bf16(v0[0], v0[1]); w.y = cvt_pk_bf16(v0[2], v0[3]); w.z = cvt_pk_bf16(v1[0], v1[1]); w.w = cvt_pk_bf16(v1[2], v1[3]);
                *(u32x4*)(base + r * ld + col0 + g2 * 32) = w; } }
    } else if (mode == 4) {
        const int pm = u.pm; int bl, isctx; if (pm < 64) { isctx = 0; bl = pm >> 4; } else { isctx = 1; bl = pm - 64; }
        const int b = E.half * NHB + bl; const int mb = isctx ? 8 : b;
        const float* mv = E.modl + (size_t)mb * 6144 + E.gidx * 1024;
        float* xb = isctx ? (E.xctx + (size_t)b * TC * DM) : (E.xlat + ((size_t)b * TL + (size_t)(pm & 15) * BM) * DM);
        const int lrow0 = wr * 64 + fr, col0 = u.pn * BN + wc * 64 + 4 * fq;
#pragma unroll
        for (int n = 0; n < 4; ++n) { const f32x4 mm = *(const f32x4*)(mv + col0 + n * 16);
#pragma unroll
            for (int m = 0; m < 4; ++m) { f32x4* q = (f32x4*)(xb + (size_t)(lrow0 + m * 16) * DM + col0 + n * 16); *q = *q + mm * acc[m][n]; } }
    } else {
        float* base = (float*)E.O + (size_t)u.seg * E.seg_stride; const int col0 = u.pn * BN + wc * 64 + 4 * fq;
#pragma unroll
        for (int m = 0; m < 4; ++m)
#pragma unroll
            for (int n = 0; n < 4; ++n) *(f32x4*)(base + (size_t)(row0 + m * 16) * E.ldc + col0 + n * 16) = acc[m][n];
    }
}

__device__ void ph_setup(const Params& p, float* shf) {
    const size_t gt = (size_t)blockIdx.x * 512 + get_tid(), gn = (size_t)gridDim.x * 512;
    { const f32x4* s = (const f32x4*)IN(0); f32x4* d = (f32x4*)p.out; const size_t n = (size_t)NBATCH * TL * DM / 4; for (size_t i = gt; i < n; i += gn) d[i] = s[i]; }
    { const f32x4* s = (const f32x4*)IN(2); f32x4* d = (f32x4*)(p.ws + WS_XCTX); const size_t n = (size_t)NBATCH * TC * DM / 4; for (size_t i = gt; i < n; i += gn) d[i] = s[i]; }
    { float* modp = (float*)(p.ws + WS_MODP); const float* c = IN(1); const float* cc = IN(3); const float* wa = IN(4);
      const size_t items = (size_t)16 * 2 * 6144;
      for (size_t it = gt; it < items; it += gn) { const int n = (int)(it % 6144); const int l = (int)((it / 6144) & 1); const int kc = (int)(it / (6144 * 2));
          float a[9]; for (int j = 0; j < 9; ++j) a[j] = 0.f;
          for (int k = kc * 64; k < kc * 64 + 64; ++k) { const float w = wa[((size_t)l * 1024 + k) * 6144 + n];
#pragma unroll
              for (int j = 0; j < 8; ++j) a[j] += siluf_(c[j * 1024 + k]) * w;
              a[8] += siluf_(cc[k]) * w; }
          for (int j = 0; j < 9; ++j) modp[(((size_t)kc * 2 + l) * 9 + j) * 6144 + n] = a[j]; } }
    { float* rc = (float*)(p.ws + WS_ROPE); float* rs = rc + 4096 * 32;
      for (size_t i = gt; i < (size_t)4096 * 32; i += gn) { const int t = (int)(i >> 5), j = (int)(i & 31); const float inv = powf(10000.0f, -(float)(j & 15) / 16.0f);
          const float pos = (j < 16) ? (float)(t >> 6) : (float)(t & 63); const float ang = pos * inv; float s, c2; sincosf(ang, &s, &c2); rc[i] = c2; rs[i] = s; } }
    { bf16_t* cm = (bf16_t*)(p.ws + WS_CMAT); bf16_t* sm = (bf16_t*)(p.ws + WS_SMAT);
      for (size_t i = gt; i < (size_t)2048 * 2048; i += gn) { const int tp = (int)(i >> 11), k = (int)(i & 2047); const int m = (tp * k) & 4095; float s, c2; sincospif((float)m * (1.0f / 2048.0f), &s, &c2);
          cm[i] = f2bf(c2); sm[i] = f2bf(s); } }
}
__device__ void ph_modreduce(const Params& p) {
    const size_t gt = (size_t)blockIdx.x * 512 + get_tid(), gn = (size_t)gridDim.x * 512;
    const float* modp = (const float*)(p.ws + WS_MODP); float* mod = (float*)(p.ws + WS_MOD); const float* ba = IN(5);
    for (size_t i = gt; i < (size_t)2 * 9 * 6144; i += gn) { const int n = (int)(i % 6144); const int l = (int)(i / (9 * 6144));
        float a = ba[(size_t)l * 6144 + n]; for (int kc = 0; kc < 16; ++kc) a += modp[(size_t)kc * 2 * 9 * 6144 + i]; mod[i] = a; }
}
__device__ void tconv(const float* src, int lds_, int K, int N, bf16_t* dst, int ldd, bool win_scale, float* tile) {
    const int tid = get_tid(); const int ntn = N / 64, ntiles = (K / 64) * ntn;
    for (int id = blockIdx.x; id < ntiles; id += gridDim.x) {
        const int k0 = (id / ntn) * 64, n0 = (id % ntn) * 64;
        float sc = 1.0f; if (win_scale && ((n0 < 256) || (n0 >= 1280 && n0 < 1536))) sc = 0.125f;
        { const int j = tid & 63, i0 = tid >> 6;
#pragma unroll
          for (int q = 0; q < 8; ++q) { const int k = i0 + 8 * q; tile[k * 65 + j] = src[(size_t)(k0 + k) * lds_ + n0 + j] * sc; } }
        __syncthreads();
        { const int n = tid >> 3, kk = (tid & 7) * 8; float v[8];
#pragma unroll
          for (int q = 0; q < 8; ++q) v[q] = tile[(kk + q) * 65 + n];
          u32x4 w; w.x = cvt_pk_bf16(v[0], v[1]); w.y = cvt_pk_bf16(v[2], v[3]); w.z = cvt_pk_bf16(v[4], v[5]); w.w = cvt_pk_bf16(v[6], v[7]);
          *(u32x4*)(dst + (size_t)(n0 + n) * ldd + k0 + kk) = w; }
        __syncthreads();
    }
}
__device__ void ph_wconv(const Params& p, int l, float* shf) {
    bf16_t* w1t = (bf16_t*)(p.ws + WS_W1T);
    tconv(IN(8) + (size_t)l * 1024 * 3072, 3072, 1024, 2816, w1t, 1024, true, shf);
    for (int i = 0; i < 4; ++i) tconv(IN(28) + ((size_t)l * 4 + i) * 1024 * 1024, 1024, 1024, 1024, (bf16_t*)(p.ws + WS_WGT) + (size_t)i * 1024 * 1024, 1024, false, shf);
    for (int i = 0; i < 4; ++i) tconv(IN(30) + ((size_t)l * 4 + i) * 256 * 1024, 1024, 256, 1024, (bf16_t*)(p.ws + WS_WBRT) + (size_t)i * 1024 * 256, 256, false, shf);
    tconv(IN(31) + (size_t)l * 1024 * 1024, 1024, 1024, 1024, (bf16_t*)(p.ws + WS_WOUTT), 1024, false, shf);
    tconv(IN(32) + (size_t)l * 1024 * 5632, 5632, 1024, 5632, (bf16_t*)(p.ws + WS_WUPT), 1024, false, shf);
    tconv(IN(35) + (size_t)l * 2816 * 1024, 1024, 2816, 1024, (bf16_t*)(p.ws + WS_WDNT), 2816, false, shf);
    const size_t gt = (size_t)blockIdx.x * 512 + get_tid(), gn = (size_t)gridDim.x * 512;
    const float* win = IN(8) + (size_t)l * 1024 * 3072; const float* mu = IN(15) + (size_t)l * 3 * 1024;
    for (size_t i = gt; i < (size_t)NAUX * 1024; i += gn) {
        const int nn = (int)(i >> 10), k = (int)(i & 1023); float v = 0.f;
        if (nn < 512) { const int ri = nn >> 8, h = (nn >> 6) & 3, cp = nn & 63; const float* wr = win + (size_t)k * 3072 + 2816 + h * 64; float a = 0.f;
            for (int c = 0; c < 64; ++c) { const int m = (c * cp) & 63; float s, c2; sincospif((float)m * (1.0f / 32.0f), &s, &c2); a += wr[c] * (ri ? -s : c2); } v = a; }
        else if (nn < 544) { const int j = nn - 512, dr = j >> 4, jj = j & 15; v = IN(9)[(((size_t)l * 2 + dr) * 1024 + k) * 16 + jj]; }
        else if (nn < 672) { const int j = nn - 544, dr = j >> 6, jj = j & 63; v = IN(17)[(((size_t)l * 2 + dr) * 1024 + k) * 64 + jj]; }
        else if (nn < 800) { const int j = nn - 672, dr = j >> 6, jj = j & 63; v = mu[k] * IN(17)[(((size_t)l * 2 + dr) * 1024 + k) * 64 + jj]; }
        else if (nn < 928) { const int j = nn - 800, dr = j >> 6, jj = j & 63; v = IN(20)[(((size_t)l * 2 + dr) * 1024 + k) * 64 + jj]; }
        else if (nn < 1056) { const int j = nn - 928, dr = j >> 6, jj = j & 63; v = mu[1024 + k] * IN(20)[(((size_t)l * 2 + dr) * 1024 + k) * 64 + jj]; }
        else if (nn < 1216) { const int jj = nn - 1056; v = IN(22)[((size_t)l * 1024 + k) * 160 + jj]; }
        else if (nn < 1376) { const int jj = nn - 1216; v = mu[2048 + k] * IN(22)[((size_t)l * 1024 + k) * 160 + jj]; }
        w1t[(size_t)(2816 + nn) * 1024 + k] = f2bf(v);
    }
    bf16_t* w2t = (bf16_t*)(p.ws + WS_W2T);
    for (size_t i = gt; i < (size_t)N2 * K2; i += gn) {
        const int n = (int)(i >> 9), k = (int)(i & 511); const int grp = n >> 8, c = n & 255; float v = 0.f;
        if (grp < 2) { const int kk = k - 64 * grp; if (kk >= 0 && kk < 64) v = IN(18)[(((size_t)l * 2 + grp) * 64 + kk) * 256 + c]; }
        else if (grp < 4) { const int d = grp - 2, kk = k - 128 - 64 * d; if (kk >= 0 && kk < 64) v = IN(21)[(((size_t)l * 2 + d) * 64 + kk) * 256 + c]; }
        else if (grp == 4) { const int kk = k - 256; if (kk >= 0 && kk < 160) v = IN(23)[((size_t)l * 160 + kk) * 256 + c]; }
        else { const int d = grp - 5, kk = k - 416 - 16 * d; if (kk >= 0 && kk < 16) v = IN(10)[(((size_t)l * 2 + d) * 16 + kk) * 256 + c]; }
        w2t[i] = f2bf(v);
    }
}

__device__ void ph_norm(const Params& p, int l, int half, int which, int nrows) {
    const int wv = get_tid() >> 6, lane = get_tid() & 63;
    const float* g = IN(which ? 7 : 6) + (size_t)l * 1024; const float* modl = (const float*)(p.ws + WS_MOD) + (size_t)l * 9 * 6144;
    bf16_t* hb = (bf16_t*)(p.ws + WS_HB);
    for (int r = blockIdx.x * 8 + wv; r < nrows; r += gridDim.x * 8) {
        int isctx, bl, t; rowinfo(r, isctx, bl, t); const int mb = isctx ? 8 : half * NHB + bl;
        const float* x = xrow_ptr(p, half, r); const float* sh = modl + (size_t)mb * 6144 + (which ? 3 : 0) * 1024; const float* sc = sh + 1024;
        f32x4 v[4]; float ss = 0.f;
#pragma unroll
        for (int q = 0; q < 4; ++q) { v[q] = *(const f32x4*)(x + q * 256 + lane * 4); ss += v[q][0] * v[q][0] + v[q][1] * v[q][1] + v[q][2] * v[q][2] + v[q][3] * v[q][3]; }
        ss = wave_sum(ss); const float rs = rsqrtf(ss * (1.0f / 1024.0f) + EPSF);
#pragma unroll
        for (int q = 0; q < 4; ++q) { const int c = q * 256 + lane * 4; const f32x4 gg = *(const f32x4*)(g + c), s1 = *(const f32x4*)(sc + c), s0 = *(const f32x4*)(sh + c);
            float o[4];
#pragma unroll
            for (int j = 0; j < 4; ++j) o[j] = v[q][j] * rs * gg[j] * (1.0f + s1[j]) + s0[j];
            u32x2 w; w.x = cvt_pk_bf16(o[0], o[1]); w.y = cvt_pk_bf16(o[2], o[3]); *(u32x2*)(hb + (size_t)r * 1024 + c) = w; }
    }
}
__device__ void ph_final(const Params& p) {
    const int wv = get_tid() >> 6, lane = get_tid() & 63; const float* g = IN(36);
    for (int r = blockIdx.x * 8 + wv; r < NBATCH * TL; r += gridDim.x * 8) {
        float* x = p.out + (size_t)r * DM; f32x4 v[4]; float ss = 0.f;
#pragma unroll
        for (int q = 0; q < 4; ++q) { v[q] = *(const f32x4*)(x + q * 256 + lane * 4); ss += v[q][0] * v[q][0] + v[q][1] * v[q][1] + v[q][2] * v[q][2] + v[q][3] * v[q][3]; }
        ss = wave_sum(ss); const float rs = rsqrtf(ss * (1.0f / 1024.0f) + EPSF);
#pragma unroll
        for (int q = 0; q < 4; ++q) { const int c = q * 256 + lane * 4; const f32x4 gg = *(const f32x4*)(g + c); f32x4 o;
#pragma unroll
            for (int j = 0; j < 4; ++j) o[j] = v[q][j] * rs * gg[j];
            *(f32x4*)(x + c) = o; }
    }
}

__device__ void ph_prepA(const Params& p, float* shf) {
    const int tid = get_tid(), wv = tid >> 6, lane = tid & 63;
    const bf16_t* paux = (const bf16_t*)(p.ws + WS_PAUX); bf16_t* a2 = (bf16_t*)(p.ws + WS_A2);
    for (int r = blockIdx.x * 8 + wv; r < RH; r += gridDim.x * 8) {
        int isctx, bl, t; rowinfo(r, isctx, bl, t); const int slen = isctx ? TC : TL; const bool hp = t > 0, hn = t < slen - 1;
        const bf16_t* pc = paux + (size_t)r * NAUX; const bf16_t* pp = pc - NAUX; const bf16_t* pn = pc + NAUX;
#pragma unroll
        for (int q = 0; q < 8; ++q) { const int j = lane + 64 * q; float v = 0.f;
            if (j < 416) { int ph, qm; if (j < 128) { ph = 544 + j; qm = 672 + j; } else if (j < 256) { ph = 800 + (j - 128); qm = 928 + (j - 128); } else { ph = 1056 + (j - 256); qm = 1216 + (j - 256); }
                const float s = bf2f(pc[ph]) + 0.5f * ((hp ? bf2f(pp[qm]) : 0.f) + (hn ? bf2f(pn[qm]) : 0.f)) - bf2f(pc[qm]);
                v = (j < 128) ? tanhf(s) : ((j < 256) ? s : sigmoidf_(s)); }
            else if (j < 448) v = bf2f(pc[512 + (j - 416)]);
            a2[(size_t)r * K2 + j] = f2bf(v); }
    }
    bf16_t* ert = (bf16_t*)(p.ws + WS_ERT); bf16_t* oit = (bf16_t*)(p.ws + WS_OIT);
    for (int id = blockIdx.x; id < 1024; id += gridDim.x) {
        const int kt = id & 31, ntile = (id >> 5) & 3, ri = (id >> 7) & 1, bl = id >> 8; const int k0 = kt * 64, n0 = ntile * 64;
        { const int j = tid & 63, i0 = tid >> 6;
#pragma unroll
          for (int q = 0; q < 8; ++q) { const int i = i0 + 8 * q, k = k0 + i; const float x = bf2f(paux[(size_t)(bl * TL + k) * NAUX + ri * 256 + n0 + j]);
              float xm = 0.f; if (k > 0) xm = bf2f(paux[(size_t)(bl * TL + (4096 - k)) * NAUX + ri * 256 + n0 + j]);
              shf[i * 65 + j] = ri ? (x - xm) : (x + xm); } }
        __syncthreads();
        { const int n = tid >> 3, kk = (tid & 7) * 8; float v[8];
#pragma unroll
          for (int q = 0; q < 8; ++q) v[q] = shf[(kk + q) * 65 + n];
          u32x4 w; w.x = cvt_pk_bf16(v[0], v[1]); w.y = cvt_pk_bf16(v[2], v[3]); w.z = cvt_pk_bf16(v[4], v[5]); w.w = cvt_pk_bf16(v[6], v[7]);
          *(u32x4*)((ri ? oit : ert) + (size_t)(bl * 256 + n0 + n) * 2048 + k0 + kk) = w; }
        __syncthreads();
    }
    const size_t gt = (size_t)blockIdx.x * 512 + tid, gn = (size_t)gridDim.x * 512;
    { bf16_t* gc = (bf16_t*)(p.ws + WS_GC); for (size_t i = gt; i < (size_t)RCH * 512; i += gn) { const int rc = (int)(i >> 9), c = (int)(i & 511); gc[i] = paux[(size_t)(RLH + rc) * NAUX + c]; } }
    { float* g2 = (float*)(p.ws + WS_GR2048); for (size_t i = gt; i < (size_t)NHB * 256; i += gn) { const int bl = (int)(i >> 8), n = (int)(i & 255); g2[i] = bf2f(paux[(size_t)(bl * TL + 2048) * NAUX + n]); } }
    { float* ny = (float*)(p.ws + WS_NYQP); for (size_t i = gt; i < (size_t)NHB * 32 * 256; i += gn) { const int n = (int)(i & 255), s = (int)((i >> 8) & 31), bl = (int)(i >> 13); float a = 0.f;
          for (int tt = 0; tt < 128; ++tt) { const int t = s * 128 + tt; const float x = bf2f(paux[(size_t)(bl * TL + t) * NAUX + n]); a += (tt & 1) ? -x : x; } ny[i] = a; } }
}

__device__ void ph_prepB(const Params& p, int l) {
    const int wv = get_tid() >> 6, d = get_tid() & 63;
    bf16_t* pm = (bf16_t*)(p.ws + WS_PMAIN); const bf16_t* pre2 = (const bf16_t*)(p.ws + WS_PRE2);
    bf16_t* oR = (bf16_t*)(p.ws + WS_RW_R); bf16_t* oV = (bf16_t*)(p.ws + WS_RW_V); bf16_t* oN = (bf16_t*)(p.ws + WS_RW_NKK);
    bf16_t* oB = (bf16_t*)(p.ws + WS_RW_B); bf16_t* oKD = (bf16_t*)(p.ws + WS_RW_KD); float* oW = (float*)(p.ws + WS_RW_W); float* oGA = (float*)(p.ws + WS_GA);
    bf16_t* oG = (bf16_t*)(p.ws + WS_GRW); float* oBo = (float*)(p.ws + WS_BONUS);
    const float* cw = IN(14) + (size_t)l * 3 * 768; const float* ropec = (const float*)(p.ws + WS_ROPE); const float* ropes = ropec + 4096 * 32;
    const size_t AE = (size_t)RH * 256;
    for (int it = blockIdx.x * 8 + wv; it < RH * 4; it += gridDim.x * 8) {
        const int r = it >> 2, h = it & 3, c = h * 64 + d;
        int isctx, bl, t; rowinfo(r, isctx, bl, t); const int slen = isctx ? TC : TL; const bool hp = t > 0, hn = t < slen - 1;
        const bf16_t* pc = pm + (size_t)r * NMAIN; const bf16_t* pp = pc - NMAIN; const bf16_t* pn = pc + NMAIN;
        float rkv[3];
#pragma unroll
        for (int j = 0; j < 3; ++j) { const int col = 2048 + j * 256 + c; const int wc = j * 256 + c;
            rkv[j] = (hp ? bf2f(pp[col]) : 0.f) * cw[wc] + bf2f(pc[col]) * cw[768 + wc] + (hn ? bf2f(pn[col]) : 0.f) * cw[1536 + wc]; }
        const float rr = rkv[0], kc = rkv[1], vc = rkv[2];
        float kk = kc * IN(24)[l * 256 + c]; const float ssq = wave_sum(kk * kk); kk *= rsqrtf(ssq + EPSF);
        const float ka = IN(25)[l * 256 + c], rk = IN(26)[l * 256 + c];
        const bf16_t* q2 = pre2 + (size_t)r * N2; float bonus = 0.f; const size_t o = (size_t)r * 256 + c;
#pragma unroll
        for (int dr = 0; dr < 2; ++dr) {
            const float u = IN(16)[(l * 2 + dr) * 256 + c] + bf2f(q2[dr * 256 + c]);
            const float wraw = -softplusf_(-u) - 0.5f; const float dec = __expf(-__expf(wraw));
            const float a = sigmoidf_(IN(19)[(l * 2 + dr) * 256 + c] + bf2f(q2[512 + dr * 256 + c]));
            const float kd = kc * (1.0f + (a - 1.0f) * ka); const float bb = kk * a;
            bonus += wave_sum(rr * kd * rk) * vc;
            oW[dr * AE + o] = dec; oB[dr * AE + o] = f2bf(bb); oKD[dr * AE + o] = f2bf(kd);
            const float z = bf2f(q2[1280 + dr * 256 + c]) + IN(11)[(l * 2 + dr) * 256 + c];
            oGA[dr * AE + o] = -softplusf_(-z) * (1.0f / 16.0f);
        }
        oR[o] = f2bf(rr); oV[o] = f2bf(vc); oN[o] = f2bf(-kk); oBo[o] = bonus; oG[o] = q2[1024 + c];
        if (!isctx) {
            const float cs = ropec[t * 32 + (d & 31)], sn = ropes[t * 32 + (d & 31)];
#pragma unroll
            for (int j = 0; j < 2; ++j) { bf16_t* e = pm + (size_t)r * NMAIN + 1024 + j * 256 + c; const float x = bf2f(*e); const float y = __shfl_xor(x, 32, 64);
                const float ov = (d < 32) ? (x * cs - y * sn) : (y * sn + x * cs); *e = f2bf(ov); }
        }
    }
}

__device__ void scan_rwkv(const Params& p, int seq, int rq, unsigned char* shm) {
    const int tid = get_tid(), wv = tid >> 6, lane = tid & 63, rrow = lane >> 4, ks = lane & 15;
    const int bl = seq >> 3, h = (seq >> 1) & 3, dr = seq & 1;
    const int rowl = (wv & 3) * 4 + rrow;
    const int row = rq * 16 + rowl;
    const size_t AE = (size_t)RH * 256;
    float* buf = (float*)shm;
    float* ybuf = (float*)(shm + 98304);
    const int sst = tid >> 4, sc4 = (tid & 15) * 4;
    f32x4 st = (f32x4){0.f, 0.f, 0.f, 0.f};
    f32x4 rg[6];
    constexpr int NCH = (TC + TL) / 32;
    auto tokrow = [&](int pidx) -> int { if (pidx < TC) { const int tt = dr ? (TC - 1 - pidx) : pidx; return RLH + bl * TC + tt; } const int q = pidx - TC; const int tt = dr ? (TL - 1 - q) : q; return bl * TL + tt; };
    auto ld_bf4 = [&](const bf16_t* base, size_t off) -> f32x4 { const u32x2 w = *(const u32x2*)(base + off); f32x4 v; v[0] = __uint_as_float(w.x << 16); v[1] = __uint_as_float(w.x & 0xFFFF0000u); v[2] = __uint_as_float(w.y << 16); v[3] = __uint_as_float(w.y & 0xFFFF0000u); return v; };
    auto load_regs = [&](int ch) {
        const int r = tokrow(ch * 32 + sst); const int c = h * 64 + sc4; const size_t o = (size_t)r * 256 + c;
        rg[0] = ld_bf4((const bf16_t*)(p.ws + WS_RW_NKK), o); rg[1] = *(const f32x4*)((const float*)(p.ws + WS_RW_W) + dr * AE + o);
        rg[2] = ld_bf4((const bf16_t*)(p.ws + WS_RW_B), dr * AE + o); rg[3] = ld_bf4((const bf16_t*)(p.ws + WS_RW_KD), dr * AE + o);
        rg[4] = ld_bf4((const bf16_t*)(p.ws + WS_RW_R), o); rg[5] = ld_bf4((const bf16_t*)(p.ws + WS_RW_V), o);
    };
    auto store_lds = [&](int b) {
        float* bb = buf + (size_t)b * 6 * 2048 + sst * 64 + sc4;
#pragma unroll
        for (int v = 0; v < 6; ++v) *(f32x4*)(bb + v * 2048) = rg[v];
    };
    bf16_t* outb = (bf16_t*)(p.ws + WS_SO) + (size_t)(4 + dr) * AE;
    load_regs(0); store_lds(0); __syncthreads();
    for (int ch = 0; ch < NCH; ++ch) {
        if (ch + 1 < NCH) load_regs(ch + 1);
        const float* bb = buf + (size_t)(ch & 1) * 6 * 2048; float* yb = ybuf + (ch & 1) * 512;
        if (wv < 4) {
#pragma unroll 2
            for (int s = 0; s < 32; ++s) {
                const float* bs = bb + s * 64 + ks * 4;
                const f32x4 a = *(const f32x4*)(bs), w = *(const f32x4*)(bs + 1 * 2048), b = *(const f32x4*)(bs + 2 * 2048);
                const f32x4 kd = *(const f32x4*)(bs + 3 * 2048), rv = *(const f32x4*)(bs + 4 * 2048); const float vv = bb[5 * 2048 + s * 64 + row];
                float sa = st[0] * a[0] + st[1] * a[1] + st[2] * a[2] + st[3] * a[3]; sa = row16_allsum(sa);
#pragma unroll
                for (int j = 0; j < 4; ++j) st[j] = st[j] * w[j] + (sa * b[j] + vv * kd[j]);
                float y = st[0] * rv[0] + st[1] * rv[1] + st[2] * rv[2] + st[3] * rv[3]; y = row16_allsum(y);
                if (ks == 0) yb[s * 16 + rowl] = y;
            }
        }
        if (ch + 1 < NCH) store_lds((ch + 1) & 1);
        __syncthreads();
        if (tid < 256) { const int s = tid >> 3, r2 = (tid & 7) * 2; const int r = tokrow(ch * 32 + s);
          const unsigned w = cvt_pk_bf16(yb[s * 16 + r2], yb[s * 16 + r2 + 1]);
          *(unsigned*)(outb + (size_t)r * 256 + h * 64 + rq * 16 + r2) = w; }
    }
}

template <int MIX  >
__device__ void scan_chunked(const Params& p, int seq, unsigned char* shm) {
    const int tid = get_tid(), wv = tid >> 6, lane = tid & 63, fr = lane & 15, fq = lane >> 4;
    const int bl = seq >> 3, h = (seq >> 1) & 3, dr = seq & 1;
    constexpr int LD = 72;
    bf16_t* Qt = (bf16_t*)shm; bf16_t* Kt = Qt + 64 * LD; bf16_t* KhT = Kt + 64 * LD; bf16_t* Vt = KhT + 64 * LD; bf16_t* Pm = Vt + 64 * LD; bf16_t* St = Pm + 64 * LD; bf16_t* Ot = St + 64 * LD;
    float* Bc = (float*)(shm + 7 * 64 * LD * 2);
    const size_t AE = (size_t)RH * 256;
    const bf16_t* pm = (const bf16_t*)(p.ws + WS_PMAIN); const float* ga = (const float*)(p.ws + WS_GA) + dr * AE;
    const int cbase = (MIX == 1) ? 0 : 1024;
    float lg = 0.f; if (MIX == 2) { const int hh = dr ? (3 - h) : h; lg = log1pf(-exp2f(-5.0f - (float)hh)); }
    bf16_t* outb = (bf16_t*)(p.ws + WS_SO) + (size_t)((MIX == 1 ? 0 : 2) + dr) * AE;
    auto tokrow = [&](int pidx) -> int { if (pidx < TC) { const int tt = dr ? (TC - 1 - pidx) : pidx; return RLH + bl * TC + tt; } const int q = pidx - TC; const int tt = dr ? (TL - 1 - q) : q; return bl * TL + tt; };
    f32x4 Sacc[2]; Sacc[0] = (f32x4){0.f, 0.f, 0.f, 0.f}; Sacc[1] = Sacc[0];
    for (int i = tid; i < 64 * LD / 2; i += 512) ((unsigned*)St)[i] = 0u;
    const int ti_ = tid >> 3, d8 = (tid & 7) * 8;
    constexpr int NCHK = (TC + TL) / 64;
    __syncthreads();
    for (int ch = 0; ch < NCHK; ++ch) {
        const int r = tokrow(ch * 64 + ti_);
        __syncthreads();
        if (MIX == 1) {
            const f32x4 l0 = *(const f32x4*)(ga + (size_t)r * 256 + h * 64 + d8), l1 = *(const f32x4*)(ga + (size_t)r * 256 + h * 64 + d8 + 4);
            *(f32x4*)(Bc + ti_ * 64 + d8) = l0; *(f32x4*)(Bc + ti_ * 64 + d8 + 4) = l1;
            __syncthreads();
            const int d = tid & 63, sg = tid >> 6;
            float run = 0.f;
#pragma unroll
            for (int q = 0; q < 8; ++q) { run += Bc[(sg * 8 + q) * 64 + d]; Bc[(sg * 8 + q) * 64 + d] = run; }
            __syncthreads();
            float offs = 0.f; for (int s2 = 0; s2 < sg; ++s2) offs += Bc[(s2 * 8 + 7) * 64 + d];
            __syncthreads();
#pragma unroll
            for (int q = 0; q < 8; ++q) Bc[(sg * 8 + q) * 64 + d] += offs;
            __syncthreads();
        }
        {
            const bf16_t* src = pm + (size_t)r * NMAIN + cbase + h * 64 + d8;
            float qv[8], kv[8], vv[8]; unpack8(*(const u32x4*)(src), qv); unpack8(*(const u32x4*)(src + 256), kv); unpack8(*(const u32x4*)(src + 512), vv);
            float qo[8], ko[8];
#pragma unroll
            for (int j = 0; j < 8; ++j) { float b, be; if (MIX == 1) { b = Bc[ti_ * 64 + d8 + j]; be = Bc[63 * 64 + d8 + j]; } else { b = (float)(ti_ + 1) * lg; be = 64.0f * lg; }
                qo[j] = qv[j] * __expf(b); ko[j] = kv[j] * __expf(-b);
                KhT[(d8 + j) * LD + ti_] = f2bf(kv[j] * __expf(be - b)); Vt[(d8 + j) * LD + ti_] = f2bf(vv[j]); }
            u32x4 w; w.x = cvt_pk_bf16(qo[0], qo[1]); w.y = cvt_pk_bf16(qo[2], qo[3]); w.z = cvt_pk_bf16(qo[4], qo[5]); w.w = cvt_pk_bf16(qo[6], qo[7]); *(u32x4*)(Qt + ti_ * LD + d8) = w;
            w.x = cvt_pk_bf16(ko[0], ko[1]); w.y = cvt_pk_bf16(ko[2], ko[3]); w.z = cvt_pk_bf16(ko[4], ko[5]); w.w = cvt_pk_bf16(ko[6], ko[7]); *(u32x4*)(Kt + ti_ * LD + d8) = w;
        }
        __syncthreads();
#pragma unroll
        for (int q = 0; q < 2; ++q) { const int t = wv * 2 + q, ti = t >> 2, tj = t & 3; f32x4 acc = (f32x4){0.f, 0.f, 0.f, 0.f};
            {
#pragma unroll
                for (int kk = 0; kk < 2; ++kk) { const bf16x8 a = *(const bf16x8*)(Qt + (ti * 16 + fr) * LD + kk * 32 + fq * 8), b = *(const bf16x8*)(Kt + (tj * 16 + fr) * LD + kk * 32 + fq * 8);
                    acc = __builtin_amdgcn_mfma_f32_16x16x32_bf16(a, b, acc, 0, 0, 0); } }
#pragma unroll
            for (int j = 0; j < 4; ++j) { const int i = ti * 16 + fq * 4 + j, jj = tj * 16 + fr; Pm[i * LD + jj] = f2bf((jj <= i) ? acc[j] : 0.f); } }
        __syncthreads();
#pragma unroll
        for (int q = 0; q < 2; ++q) { const int t = wv * 2 + q, ti = t >> 2, te = t & 3; f32x4 acc = (f32x4){0.f, 0.f, 0.f, 0.f};
#pragma unroll
            for (int kk = 0; kk < 2; ++kk) { const bf16x8 a = *(const bf16x8*)(Pm + (ti * 16 + fr) * LD + kk * 32 + fq * 8), b = *(const bf16x8*)(Vt + (te * 16 + fr) * LD + kk * 32 + fq * 8);
                acc = __builtin_amdgcn_mfma_f32_16x16x32_bf16(a, b, acc, 0, 0, 0);
                const bf16x8 a2 = *(const bf16x8*)(Qt + (ti * 16 + fr) * LD + kk * 32 + fq * 8), b2 = *(const bf16x8*)(St + (te * 16 + fr) * LD + kk * 32 + fq * 8);
                acc = __builtin_amdgcn_mfma_f32_16x16x32_bf16(a2, b2, acc, 0, 0, 0); }
#pragma unroll
            for (int j = 0; j < 4; ++j) { const int i = ti * 16 + fq * 4 + j; Ot[i * LD + te * 16 + fr] = f2bf(acc[j]); } }
        __syncthreads();
        *(u32x4*)(outb + (size_t)r * 256 + h * 64 + d8) = *(const u32x4*)(Ot + ti_ * LD + d8);
#pragma unroll
        for (int q = 0; q < 2; ++q) { const int t = wv * 2 + q, td = t >> 2, te = t & 3;
#pragma unroll
            for (int j = 0; j < 4; ++j) { const float be = (MIX == 1) ? Bc[63 * 64 + td * 16 + fq * 4 + j] : 64.0f * lg; Sacc[q][j] *= __expf(be); }
#pragma unroll
            for (int kk = 0; kk < 2; ++kk) { const bf16x8 a = *(const bf16x8*)(KhT + (td * 16 + fr) * LD + kk * 32 + fq * 8), b = *(const bf16x8*)(Vt + (te * 16 + fr) * LD + kk * 32 + fq * 8);
                Sacc[q] = __builtin_amdgcn_mfma_f32_16x16x32_bf16(a, b, Sacc[q], 0, 0, 0); }
            u32x2 w; w.x = (unsigned)f2bf(Sacc[q][0]) | ((unsigned)f2bf(Sacc[q][1]) << 16); w.y = (unsigned)f2bf(Sacc[q][2]) | ((unsigned)f2bf(Sacc[q][3]) << 16); *(u32x2*)(St + (te * 16 + fr) * LD + td * 16 + fq * 4) = w; }
        __syncthreads();
    }
}

__device__ void ph_branch(const Params& p, int l, int nrows, float* shf) {
    const int tid = get_tid(), wv = tid >> 6, d = tid & 63;
    if (tid < 256) { float s, c2; sincospif((float)tid * (1.0f / 128.0f), &s, &c2); shf[tid] = c2; shf[256 + tid] = s; }
    __syncthreads();
    const bf16_t* pm = (const bf16_t*)(p.ws + WS_PMAIN); const bf16_t* so = (const bf16_t*)(p.ws + WS_SO); const size_t AE = (size_t)RH * 256;
    const bf16_t* grw = (const bf16_t*)(p.ws + WS_GRW); const float* bon = (const float*)(p.ws + WS_BONUS);
    const float* fc = (const float*)(p.ws + WS_FC); const float* fs = (const float*)(p.ws + WS_FS); const float* g2048 = (const float*)(p.ws + WS_GR2048);
    const float* nyq = (const float*)(p.ws + WS_NYQP); const bf16_t* gc = (const bf16_t*)(p.ws + WS_GC);
    bf16_t* outs = (bf16_t*)(p.ws + WS_OUTS);
    for (int it = blockIdx.x * 8 + wv; it < nrows * 4; it += gridDim.x * 8) {
        const int r = it >> 2, h = it & 3, c = h * 64 + d; const size_t o = (size_t)r * 256 + c;
        int isctx, bl, t; rowinfo(r, isctx, bl, t);
        const bf16_t* pc = pm + (size_t)r * NMAIN;
        float og = bf2f(so[0 * AE + o]) + bf2f(so[1 * AE + o]);
        { const float ms = wave_sum(og * og) * (1.0f / 64.0f); og = og * rsqrtf(ms + EPSF) * IN(12)[l * 256 + c] * siluf_(bf2f(pc[768 + c])); }
        float orr = bf2f(so[2 * AE + o]) + bf2f(so[3 * AE + o]);
        { const float mean = wave_sum(orr) * (1.0f / 64.0f); orr -= mean; const float var = wave_sum(orr * orr) * (1.0f / 64.0f); orr = orr * rsqrtf(var + EPSF) * IN(13)[l * 256 + c] * siluf_(bf2f(pc[1792 + c])); }
        float ow = bf2f(so[4 * AE + o]) + bf2f(so[5 * AE + o]);
        { const float mean = wave_sum(ow) * (1.0f / 64.0f); ow -= mean; const float var = wave_sum(ow * ow) * (1.0f / 64.0f); ow = (ow * rsqrtf(var + EPSF) * IN(27)[l * 256 + c] + bon[o]) * bf2f(grw[o]); }
        float of;
        if (!isctx) {
            const float sg = (t & 1) ? -1.0f : 1.0f; const int col = bl * 256 + c;
            if (t < 2048) of = fc[(size_t)t * 1024 + col] + fs[(size_t)t * 1024 + col] + sg * g2048[col];
            else if (t == 2048) { float a = 0.f; for (int s = 0; s < 32; ++s) a += nyq[((size_t)bl * 32 + s) * 256 + c]; of = a; }
            else { const int t2 = 4096 - t; of = fc[(size_t)t2 * 1024 + col] - fs[(size_t)t2 * 1024 + col] + sg * g2048[col]; }
            of *= (1.0f / 512.0f);
        } else {
            float a = 0.f; const bf16_t* gb = gc + (size_t)bl * 256 * 512 + c;
            for (int tt = 0; tt < 256; ++tt) { const int m = (tt * t) & 255; a += shf[m] * bf2f(gb[(size_t)tt * 512]) + shf[256 + m] * bf2f(gb[(size_t)tt * 512 + 256]); }
            of = a * (1.0f / 128.0f);
        }
        bf16_t* orow = outs + (size_t)r * 1024 + c;
        orow[0] = f2bf(og); orow[256] = f2bf(orr); orow[512] = f2bf(ow); orow[768] = f2bf(of);
    }
}

__device__ void ph_act(const Params& p, int l, int nrows) {
    const size_t gt = (size_t)blockIdx.x * 512 + get_tid(), gn = (size_t)gridDim.x * 512;
    const bf16_t* U = (const bf16_t*)(p.ws + WS_U); bf16_t* A = (bf16_t*)(p.ws + WS_ACT);
    const float* cw = IN(33) + (size_t)l * 3 * DFF; const float* cb = IN(34) + (size_t)l * DFF;
    const size_t items = (size_t)nrows * 352;
    for (size_t it = gt; it < items; it += gn) {
        const int r = (int)(it / 352), j0 = (int)(it % 352) * 8;
        int isctx, bl, t; rowinfo(r, isctx, bl, t); const int slen = isctx ? TC : TL; const bool hp = t > 0, hn = t < slen - 1;
        const bf16_t* uc = U + (size_t)r * 5632 + j0;
        const u32x4 z4 = (u32x4){0u, 0u, 0u, 0u};
        const u32x4 ac = *(const u32x4*)uc, ap = hp ? *(const u32x4*)(uc - 5632) : z4, an = hn ? *(const u32x4*)(uc + 5632) : z4, uu = *(const u32x4*)(uc + 2816);
        float o[8];
#pragma unroll
        for (int j = 0; j < 8; ++j) { const unsigned wcur = ac[j >> 1], wp = ap[j >> 1], wn = an[j >> 1], wu = uu[j >> 1];
            const float xc = (j & 1) ? __uint_as_float(wcur & 0xFFFF0000u) : __uint_as_float(wcur << 16), xp = (j & 1) ? __uint_as_float(wp & 0xFFFF0000u) : __uint_as_float(wp << 16),
                        xn = (j & 1) ? __uint_as_float(wn & 0xFFFF0000u) : __uint_as_float(wn << 16), xu = (j & 1) ? __uint_as_float(wu & 0xFFFF0000u) : __uint_as_float(wu << 16);
            const float a = xp * cw[j0 + j] + xc * cw[DFF + j0 + j] + xn * cw[2 * DFF + j0 + j] + cb[j0 + j];
            o[j] = siluf_(a) * xu; }
        u32x4 w; w.x = cvt_pk_bf16(o[0], o[1]); w.y = cvt_pk_bf16(o[2], o[3]); w.z = cvt_pk_bf16(o[4], o[5]); w.w = cvt_pk_bf16(o[6], o[7]);
        *(u32x4*)(A + (size_t)r * DFF + j0) = w;
    }
}

#ifndef SUBMASK
#define SUBMASK 0x3FFF
#define ALLSTEPS 1
#endif
#define ON(s) (((SUBMASK) >> (s)) & 1)
constexpr int STEPS_PER_PASS = 14, NSTEPS = 2 + 4 * STEPS_PER_PASS + 1;

__device__ __forceinline__ void run_step(const Params& p, int step, unsigned char* shm) {
    float* shf = (float*)shm; LAS unsigned char* lds = (LAS unsigned char*)shm;
    const int G = gridDim.x, c = blockIdx.x;
#ifdef ALLSTEPS
    if (step == 0) { ph_setup(p, shf); return; }
    if (step == 1) { ph_modreduce(p); ph_wconv(p, 0, shf); return; }
    if (step == NSTEPS - 1) { ph_final(p); return; }
#endif
    const int ps = step - 2, pass = ps / STEPS_PER_PASS, sub = ps % STEPS_PER_PASS, l = pass >> 1, half = pass & 1;
    const bool need_ctx = (l == 0); const int Mpost = need_ctx ? RH : RLH;
    const float* modl = (const float*)(p.ws + WS_MOD) + (size_t)l * 9 * 6144;
    Sched S; Prob P; EpiU E{}; bool do_gemm = false;
    E.xlat = p.out; E.xctx = (float*)(p.ws + WS_XCTX); E.half = half; E.modl = modl;
    switch (sub) {
    case 0: if (ON(0)) { if (l == 1 && half == 0) ph_wconv(p, 1, shf); ph_norm(p, l, half, 0, RH); } break;
    case 1: if (ON(1)) { S.init(RH, N1, 1, G, c); P = Prob{(const bf16_t*)(p.ws + WS_HB), (const bf16_t*)(p.ws + WS_W1T), 1024, 1024, 16, 0, 0};
        E.mode = 0; E.O = p.ws + WS_PMAIN; E.O2 = p.ws + WS_PAUX; do_gemm = true; } break;
    case 2: if (ON(2)) ph_prepA(p, shf); break;
    case 3: if (ON(3)) { S.init(RH, N2, 1, G, c); P = Prob{(const bf16_t*)(p.ws + WS_A2), (const bf16_t*)(p.ws + WS_W2T), K2, K2, K2 / 64, 0, 0};
        E.mode = 1; E.O = p.ws + WS_PRE2; E.ldc = N2; do_gemm = true; } break;
    case 4: if (ON(4)) ph_prepB(p, l); break;
    case 5: if (ON(5)) {
        if (c < 128) scan_rwkv(p, c >> 2, c & 3, shm);
        else if (c < NWG_SCAN) { const int seq = (c - 128) >> 1; if ((c - 128) & 1) scan_chunked<2>(p, seq, shm); else scan_chunked<1>(p, seq, shm); }
        else {
            S.init(2048, 1024, 2, G - NWG_SCAN, c - NWG_SCAN);
            P = Prob{(const bf16_t*)(p.ws + WS_CMAT), (const bf16_t*)(p.ws + WS_ERT), 2048, 2048, 32, (size_t)2048 * 2048, (size_t)1024 * 2048};
            E.mode = 5; E.O = p.ws + WS_FC; E.ldc = 1024; E.seg_stride = (size_t)2048 * 1024; do_gemm = true; } }
        break;
    case 6: if (ON(6)) ph_branch(p, l, Mpost, shf); break;
    case 7: if (ON(7)) { S.init(Mpost, 4096, 1, G, c); P = Prob{(const bf16_t*)(p.ws + WS_HB), (const bf16_t*)(p.ws + WS_WGT), 1024, 1024, 16, 0, 0};
        E.mode = 2; E.O = p.ws + WS_GBUF; E.ldc = 4096; E.bias = IN(29) + (size_t)l * 4096; do_gemm = true; } break;
    case 8: if (ON(8)) { S.init(Mpost, 1024, 4, G, c); P = Prob{(const bf16_t*)(p.ws + WS_OUTS), (const bf16_t*)(p.ws + WS_WBRT), 1024, 256, 4, 256, (size_t)1024 * 256};
        E.mode = 3; E.O = p.ws + WS_Z; E.O2 = p.ws + WS_GBUF; do_gemm = true; } break;
    case 9: if (ON(9)) { S.init(Mpost, 1024, 1, G, c); P = Prob{(const bf16_t*)(p.ws + WS_Z), (const bf16_t*)(p.ws + WS_WOUTT), 1024, 1024, 16, 0, 0};
        E.mode = 4; E.gidx = 2; do_gemm = true; } break;
    case 10: if (ON(10)) ph_norm(p, l, half, 1, Mpost); break;
    case 11: if (ON(11)) { S.init(Mpost, 5632, 1, G, c); P = Prob{(const bf16_t*)(p.ws + WS_HB), (const bf16_t*)(p.ws + WS_WUPT), 1024, 1024, 16, 0, 0};
        E.mode = 1; E.O = p.ws + WS_U; E.ldc = 5632; do_gemm = true; } break;
    case 12: if (ON(12)) ph_act(p, l, Mpost); break;
    case 13: if (ON(13)) { S.init(Mpost, 1024, 1, G, c); P = Prob{(const bf16_t*)(p.ws + WS_ACT), (const bf16_t*)(p.ws + WS_WDNT), DFF, DFF, DFF / 64, 0, 0};
        E.mode = 4; E.gidx = 5; do_gemm = true; } break;
    }
#ifndef REP_GEMM
#define REP_GEMM 1
#endif
    if (do_gemm) { gemm_phase(lds, P, S, E);
        if (REP_GEMM > 1 && E.mode != 4 && sub != 5) for (int rep = 1; rep < REP_GEMM; ++rep) gemm_phase(lds, P, S, E); }
}


#define XB_TMO      128
#define XB_XCNT(j)  (256  + 64 * (j))
#define XB_XSUB(j)  (1280 + 64 * (j))
#define XB_XGEN(j)  (2304 + 64 * (j))
#define XB_TOP      3328
#define XB_TOPGEN   3392
#define XCD_BAR_WORDS 3456
#define XB_SPIN_CAP (1u << 22)
__device__ __forceinline__ unsigned xb_ld(unsigned* p)              { return __hip_atomic_load(p, __ATOMIC_RELAXED, __HIP_MEMORY_SCOPE_AGENT); }
__device__ __forceinline__ unsigned xb_add(unsigned* p, unsigned v) { return __hip_atomic_fetch_add(p, v, __ATOMIC_RELAXED, __HIP_MEMORY_SCOPE_AGENT); }
__device__ __forceinline__ unsigned xb_xcc_id() { return (unsigned)__builtin_amdgcn_s_getreg((3 << 11) | 20) & 0xFu; }
#define XB_SPIN(cond, bar) do { unsigned _sp = 0; while (cond) { __builtin_amdgcn_s_sleep(1); \
    if ((++_sp & 255u) == 0u) { if (xb_ld(&(bar)[XB_TMO])) break; if (_sp > XB_SPIN_CAP) { atomicAdd(&(bar)[XB_TMO], 1u); break; } } } } while (0)
struct XcdBarrier { unsigned* bar; unsigned x; volatile LAS unsigned* st; };
__device__ __forceinline__ XcdBarrier xcd_barrier_post(unsigned* bar, volatile LAS unsigned* st) {
    XcdBarrier b; b.bar = bar; b.x = xb_xcc_id(); b.st = st;
    if (threadIdx.x == 0) (void)xb_add(&bar[XB_XCNT(b.x)], 1u);
    return b;
}
__device__ __forceinline__ void xcd_barrier_complete(unsigned* bar, unsigned x, unsigned& nloc, unsigned& nx) {
    const unsigned G = gridDim.x * gridDim.y * gridDim.z;
    unsigned sum, cnt, mine, sp = 0u;
    for (;;) {
        sum = 0u; cnt = 0u; mine = 0u;
#pragma unroll
        for (unsigned j = 0; j < 16; ++j) { const unsigned c = xb_ld(&bar[XB_XCNT(j)]); sum += c; cnt += (c > 0u) ? 1u : 0u; mine = (j == x) ? c : mine; }
        if (sum == G) break;
        __builtin_amdgcn_s_sleep(1);
        if ((++sp & 255u) == 0u) { if (xb_ld(&bar[XB_TMO])) break; if (sp > XB_SPIN_CAP) { atomicAdd(&bar[XB_TMO], 1u); break; } }
    }
    nloc = mine > 0u ? mine : 1u; nx = cnt > 0u ? cnt : 1u;
}
__device__ __forceinline__ void xcd_barrier(const XcdBarrier& b) {
    asm volatile("s_waitcnt vmcnt(0)" ::: "memory");
    __syncthreads();
    if (threadIdx.x == 0) {
        unsigned* bar = b.bar;
        __builtin_amdgcn_s_waitcnt(0);
        unsigned nloc = b.st[0], nx = b.st[1];
        if (nloc == 0u) { xcd_barrier_complete(bar, b.x, nloc, nx); b.st[0] = nloc; b.st[1] = nx; }
        const unsigned old = xb_add(&bar[XB_XSUB(b.x)], 1u);
        const unsigned gen = old / nloc;
        if (old + 1u == (gen + 1u) * nloc) {
            __builtin_amdgcn_fence(__ATOMIC_RELEASE, "agent");
            asm volatile("s_waitcnt vmcnt(0)" ::: "memory");
            const unsigned og = xb_add(&bar[XB_TOP], 1u);
            const unsigned tg = og / nx;
            if (og + 1u == (tg + 1u) * nx) xb_add(&bar[XB_TOPGEN], 1u);
            else XB_SPIN(xb_ld(&bar[XB_TOPGEN]) == tg, bar);
            __builtin_amdgcn_fence(__ATOMIC_ACQUIRE, "agent");
            xb_add(&bar[XB_XGEN(b.x)], 1u);
            asm volatile("s_waitcnt vmcnt(0)" ::: "memory");
        } else {
            XB_SPIN(xb_ld(&bar[XB_XGEN(b.x)]) == gen, bar);
            __builtin_amdgcn_fence(__ATOMIC_ACQUIRE, "agent");
            asm volatile("s_waitcnt vmcnt(0)" ::: "memory");
        }
    }
    __syncthreads();
}

__global__ void __launch_bounds__(512, 2) fwd_megakernel(KArgs ka) {
    unsigned char* shm = g_shm;
    cg::grid_group grid = cg::this_grid();
    if (threadIdx.x == 0) {
#pragma unroll
        for (int i = 0; i < 37; ++i) ((const float**)(g_shm + 131072))[i] = ka.in[i];
        ((unsigned*)(g_shm + 131072 + 512))[0] = 0u; ((unsigned*)(g_shm + 131072 + 512))[1] = 0u;
    }
    __syncthreads();
    XcdBarrier xb = xcd_barrier_post((unsigned*)(ka.ws + WS_BAR), (volatile LAS unsigned*)((LAS unsigned char*)g_shm + 131072 + 512));
    for (int step = ka.step_lo; step < ka.step_hi; ++step) {
        Params p; p.out = ka.out; p.ws = ka.ws;
        asm volatile("" : "+s"(p.out), "+s"(p.ws));
        run_step(p, step, shm);
        if (step + 1 < ka.step_hi) { if (step == ka.step_lo) { __syncthreads(); grid.sync(); } else xcd_barrier(xb); }
    }
}

extern "C" void kernel_launch(void* const* d_in, const int* in_sizes, int n_in, void* d_out, int out_size, void* d_ws, size_t ws_size, hipStream_t stream) {
    static int grid = 0;
    if (grid == 0) {
        if (n_in != 37 || ws_size < WS_END) { fprintf(stderr, "kernel_launch: need 37 inputs and >= %zu bytes of workspace; got n_in %d, ws %zu\n", (size_t)WS_END, n_in, ws_size); grid = -1; return; }
        if (hipFuncSetAttribute((const void*)fwd_megakernel, hipFuncAttributeMaxDynamicSharedMemorySize, LDS_BYTES) != hipSuccess) { fprintf(stderr, "kernel_launch: hipFuncSetAttribute failed\n"); grid = -1; return; }
        int dev = 0, cus = 0, per_cu = 0; (void)hipGetDevice(&dev); (void)hipDeviceGetAttribute(&cus, hipDeviceAttributeMultiprocessorCount, dev);
        (void)hipOccupancyMaxActiveBlocksPerMultiprocessor(&per_cu, (const void*)fwd_megakernel, 512, LDS_BYTES);
        if (per_cu < 1 || cus != 256) fprintf(stderr, "kernel_launch: note: cus %d per_cu %d\n", cus, per_cu);
        (void)hipGetLastError();
        grid = 256;
    }
    if (grid < 0) return;
    if (hipMemsetAsync((char*)d_ws + WS_BAR, 0, 16384, stream) != hipSuccess) { fprintf(stderr, "kernel_launch: memset of barrier words failed\n"); return; }
    KArgs p{};
    for (int i = 0; i < 37; ++i) p.in[i] = (const float*)d_in[i];
    p.out = (float*)d_out; p.ws = (unsigned char*)d_ws;
#if USE_COOP
    p.step_lo = 0; p.step_hi = NSTEPS;
    void* args[] = {&p};
    hipError_t e = hipLaunchCooperativeKernel((const void*)fwd_megakernel, dim3(grid), dim3(512), args, LDS_BYTES, stream);
    if (e != hipSuccess) fprintf(stderr, "cooperative launch failed: %s\n", hipGetErrorString(e));
#else
    for (int s = 0; s < NSTEPS; ++s) { p.step_lo = s; p.step_hi = s + 1; hipLaunchKernelGGL(fwd_megakernel, dim3(grid), dim3(512), LDS_BYTES, stream, p); }
#endif
}
```
